# Optimizing an MI355X kernel written in HIP

```python
import math
import jax, jax.numpy as jnp
from jax import lax
import numpy as np

D_MODEL = 1024
BATCH = 2
SEQ = 16384
DEPTH = 1
DEC_BATCH = 8
DEC_SEQ = 32
PAST_LEN = 1024

CHUNK = 64
Q_BLOCK = 128
POOL_WINDOWS = (2, 4, 8, 16)
POOL_GROUPS = len(POOL_WINDOWS)
POOL_WIDTH = D_MODEL // 4
POOL_GROUP_DIM = POOL_WIDTH // POOL_GROUPS
POOL_HIST = max(POOL_WINDOWS) - 1
ATTN_WIDTH = D_MODEL - POOL_WIDTH
HEAD_DIM = 64
V_DIM = 2 * HEAD_DIM
N_HEADS = ATTN_WIDTH // V_DIM
MIX_WIDTH = POOL_WIDTH + ATTN_WIDTH
IN_WIDTH = 2 * POOL_WIDTH + 4 * ATTN_WIDTH
IN_SPLITS = (POOL_WIDTH, 2 * POOL_WIDTH, 2 * POOL_WIDTH + ATTN_WIDTH,
             2 * POOL_WIDTH + 2 * ATTN_WIDTH, 2 * POOL_WIDTH + 3 * ATTN_WIDTH)
ATTN_SCALE = HEAD_DIM ** -0.5
DEEPNORM_ALPHA = (2.0 * DEPTH) ** 0.25
DEEPNORM_BETA = (8.0 * DEPTH) ** -0.25
LN_EPS = 1e-5
SUBLN_EPS = 1e-5

kernel_name = "hybrid_pool_diffattn_streaming_step"


def _lambda_init(layer_idx):
    return 0.8 - 0.6 * math.exp(-0.3 * layer_idx)


def _pool_mixer(u, hist, n_valid_hist, pool_w, pool_b, pool_scale):
    f32 = jnp.float32
    B, T, P = u.shape
    ext = jnp.concatenate([hist.astype(f32), u.astype(f32)], axis=1)
    cs = jnp.concatenate([jnp.zeros((B, 1, P), f32), jnp.cumsum(ext, axis=1)], axis=1)
    end = cs[:, POOL_HIST + 1:POOL_HIST + 1 + T]
    t = jnp.arange(T)
    outs = []
    for g, w in enumerate(POOL_WINDOWS):
        lo, hi = g * POOL_GROUP_DIM, (g + 1) * POOL_GROUP_DIM
        start = cs[:, POOL_HIST + 1 - w:POOL_HIST + 1 - w + T, lo:hi]
        cnt = jnp.minimum(w, n_valid_hist + t + 1).astype(f32)
        outs.append((end[..., lo:hi] - start) / cnt[None, :, None])
    pooled = jnp.concatenate(outs, axis=-1) - u.astype(f32)
    pg = pooled.reshape(B, T, POOL_GROUPS, POOL_GROUP_DIM)
    mixed = jnp.einsum("btgc,gcd->btgd", pg, pool_w.astype(f32)) + pool_b.astype(f32)
    return mixed.reshape(B, T, P) * pool_scale.astype(f32)


def _diff_attend(q, k, v, q_pos, k_pos, lam, lam_init, subln_g):
    f32 = jnp.float32
    s = jnp.einsum("bqhcd,bkhcd->bhcqk", q.astype(f32), k.astype(f32)) * ATTN_SCALE
    visible = (k_pos[None, :] // CHUNK) <= (q_pos[:, None] // CHUNK)
    s = jnp.where(visible[None, None, None], s, -jnp.inf)
    p = jax.nn.softmax(s, axis=-1)
    a = p[:, :, 0] - lam * p[:, :, 1]
    o = jnp.einsum("bhqk,bkhv->bqhv", a, v.astype(f32))
    o = o * lax.rsqrt(jnp.mean(o * o, axis=-1, keepdims=True) + SUBLN_EPS)
    return o * subln_g.astype(f32) * (1.0 - lam_init)


def _prompt_attention(q, k, v, lam, lam_init, subln_g):
    B, S = q.shape[:2]
    nblk = S // Q_BLOCK
    qb = q.reshape(B, nblk, Q_BLOCK, N_HEADS, 2, HEAD_DIM).transpose(1, 0, 2, 3, 4, 5)
    k_pos = jnp.arange(S)

    def one_block(args):
        q_blk, i = args
        q_pos = i * Q_BLOCK + jnp.arange(Q_BLOCK)
        return _diff_attend(q_blk, k, v, q_pos, k_pos, lam, lam_init, subln_g)

    o = lax.map(one_block, (qb, jnp.arange(nblk)))
    return o.transpose(1, 0, 2, 3, 4).reshape(B, S, N_HEADS, V_DIM)


def _layer(x, pool_hist, n_valid_hist, k_past, v_past, blocked, lam_init,
           w_in, pool_w, pool_b, pool_scale, lq1, lk1, lq2, lk2, subln_g, w_out, ln_g, ln_b):
    f32 = jnp.float32
    B, T, _ = x.shape
    proj = jnp.einsum("btd,de->bte", x, w_in)
    u, g_pool, q, k, v, g_attn = jnp.split(proj, IN_SPLITS, axis=-1)

    pool_out = _pool_mixer(u, pool_hist, n_valid_hist, pool_w, pool_b, pool_scale)

    q = q.reshape(B, T, N_HEADS, 2, HEAD_DIM)
    k_rows = k.reshape(B, T, N_HEADS, 2 * HEAD_DIM)
    v_rows = v.reshape(B, T, N_HEADS, V_DIM)
    lam = (jnp.exp(jnp.sum(lq1.astype(f32) * lk1.astype(f32)))
           - jnp.exp(jnp.sum(lq2.astype(f32) * lk2.astype(f32))) + lam_init)
    if blocked:
        attn = _prompt_attention(q, k_rows.reshape(B, T, N_HEADS, 2, HEAD_DIM), v_rows,
                                 lam, lam_init, subln_g)
    else:
        pos0 = k_past.shape[1]
        k_all = jnp.concatenate([k_past.astype(k_rows.dtype), k_rows], axis=1)
        v_all = jnp.concatenate([v_past.astype(v_rows.dtype), v_rows], axis=1)
        attn = _diff_attend(q, k_all.reshape(B, pos0 + T, N_HEADS, 2, HEAD_DIM), v_all,
                            pos0 + jnp.arange(T), jnp.arange(pos0 + T), lam, lam_init, subln_g)

    mixed = jnp.concatenate([jax.nn.silu(g_pool.astype(f32)) * pool_out,
                             jax.nn.silu(g_attn.astype(f32)) * attn.reshape(B, T, ATTN_WIDTH)],
                            axis=-1)
    out = jnp.einsum("bte,ed->btd", mixed, w_out.astype(f32))

    z = DEEPNORM_ALPHA * x.astype(f32) + out
    mu = jnp.mean(z, axis=-1, keepdims=True)
    var = jnp.mean(jnp.square(z - mu), axis=-1, keepdims=True)
    y = (z - mu) * lax.rsqrt(var + LN_EPS) * ln_g.astype(f32) + ln_b.astype(f32)

    new_pool = jnp.concatenate([pool_hist.astype(u.dtype), u], axis=1)[:, -POOL_HIST:]
    return y.astype(x.dtype), k_rows, v_rows, new_pool


def setup_inputs(seed: int = 0) -> dict:
    key = jax.random.key(seed)
    ks = jax.random.split(key, 20)
    f32 = jnp.float32
    nrm = lambda k, s: jax.random.normal(k, s, f32)
    return {
        "x_prompt": nrm(ks[0], (BATCH, SEQ, D_MODEL)),
        "x_sample": nrm(ks[1], (DEC_BATCH, DEC_SEQ, D_MODEL)),
        "cache_k": nrm(ks[2], (DEPTH, DEC_BATCH, PAST_LEN, N_HEADS, 2 * HEAD_DIM)),
        "cache_v": nrm(ks[3], (DEPTH, DEC_BATCH, PAST_LEN, N_HEADS, V_DIM)),
        "state_pool": nrm(ks[4], (DEPTH, DEC_BATCH, POOL_HIST, POOL_WIDTH)),
        "w_in": nrm(ks[5], (DEPTH, D_MODEL, IN_WIDTH)) * D_MODEL ** -0.5,
        "pool_w": nrm(ks[6], (DEPTH, POOL_GROUPS, POOL_GROUP_DIM, POOL_GROUP_DIM)) * POOL_GROUP_DIM ** -0.5,
        "pool_b": 0.01 * nrm(ks[7], (DEPTH, POOL_GROUPS, POOL_GROUP_DIM)),
        "pool_scale": 1.0 + 0.1 * nrm(ks[8], (DEPTH, POOL_WIDTH)),
        "lambda_q1": 0.1 * nrm(ks[9], (DEPTH, HEAD_DIM)),
        "lambda_k1": 0.1 * nrm(ks[10], (DEPTH, HEAD_DIM)),
        "lambda_q2": 0.1 * nrm(ks[11], (DEPTH, HEAD_DIM)),
        "lambda_k2": 0.1 * nrm(ks[12], (DEPTH, HEAD_DIM)),
        "subln_g": 1.0 + 0.01 * nrm(ks[13], (DEPTH, V_DIM)),
        "w_out": nrm(ks[14], (DEPTH, MIX_WIDTH, D_MODEL)) * (MIX_WIDTH ** -0.5) * DEEPNORM_BETA,
        "ln_g": 1.0 + 0.01 * nrm(ks[15], (DEPTH, D_MODEL)),
        "ln_b": 0.01 * nrm(ks[16], (DEPTH, D_MODEL)),
    }


def reference(x_prompt, x_sample, cache_k, cache_v, state_pool,
              w_in, pool_w, pool_b, pool_scale, lambda_q1, lambda_k1, lambda_q2, lambda_k2,
              subln_g, w_out, ln_g, ln_b):
    yp, ys = x_prompt, x_sample
    kp_l, vp_l, pp_l, ks_l, vs_l, ps_l = [], [], [], [], [], []
    n_valid_sample = min(PAST_LEN, POOL_HIST)
    for l in range(DEPTH):
        lam_init = _lambda_init(l)
        params = (w_in[l], pool_w[l], pool_b[l], pool_scale[l], lambda_q1[l], lambda_k1[l],
                  lambda_q2[l], lambda_k2[l], subln_g[l], w_out[l], ln_g[l], ln_b[l])
        zero_hist = jnp.zeros((yp.shape[0], POOL_HIST, POOL_WIDTH), yp.dtype)
        yp, kp, vp, pp = _layer(yp, zero_hist, 0, None, None, True, lam_init, *params)
        ys, kn, vn, pn = _layer(ys, state_pool[l], n_valid_sample, cache_k[l], cache_v[l],
                                False, lam_init, *params)
        kp_l.append(kp); vp_l.append(vp); pp_l.append(pp)
        ks_l.append(kn); vs_l.append(vn); ps_l.append(pn)
    k_prompt = jnp.stack(kp_l)
    v_prompt = jnp.stack(vp_l)
    pool_prompt = jnp.stack(pp_l)
    k_sample = jnp.stack(ks_l)
    v_sample = jnp.stack(vs_l)
    pool_sample = jnp.stack(ps_l)
    return (yp, ys, k_prompt, v_prompt, pool_prompt, k_sample, v_sample, pool_sample)
```

```cpp
#include <hip/hip_runtime.h>
#include <hip/hip_cooperative_groups.h>
#include <cstdio>
#include <cstdint>
namespace cg = cooperative_groups;

typedef short bf16x8 __attribute__((ext_vector_type(8)));
typedef float f32x16 __attribute__((ext_vector_type(16)));
typedef float f32x4 __attribute__((ext_vector_type(4)));
typedef float f32x2 __attribute__((ext_vector_type(2)));
typedef __bf16 bf16x2_t __attribute__((ext_vector_type(2)));
typedef unsigned u32x4 __attribute__((ext_vector_type(4)));
typedef unsigned u32x2 __attribute__((ext_vector_type(2)));
typedef unsigned short u16;

#define MFMA32(a, b, c) __builtin_amdgcn_mfma_f32_32x32x16_bf16((a), (b), (c), 0, 0, 0)
#define DI __device__ __forceinline__

constexpr int NP = 32768, NS = 256, NT = NP + NS;
constexpr int INW = 3584, SEQ = 16384, SKV = 1088;
constexpr int LDS_BYTES = 147456;
constexpr int LDS_SLOT = 147440;
constexpr int XOFF = 73728;

constexpr size_t WS_CTRL = 0;
constexpr size_t WS_XB = 4096;
constexpr size_t WS_WTIN = WS_XB + (size_t)NT * 1024 * 2;
constexpr size_t WS_WTOUT = WS_WTIN + (size_t)INW * 1024 * 2;
constexpr size_t WS_PWT = WS_WTOUT + (size_t)1024 * 1024 * 2;
constexpr size_t WS_U = WS_PWT + 32768;
constexpr size_t WS_GP = WS_U + (size_t)NT * 256 * 4;
constexpr size_t WS_QB = WS_GP + (size_t)NT * 256 * 4;
constexpr size_t WS_KB = WS_QB + (size_t)NT * 768 * 2;
constexpr size_t WS_KBS = WS_KB + (size_t)NP * 768 * 2;
constexpr size_t WS_VT = WS_KBS + (size_t)8 * SKV * 768 * 2;
constexpr size_t WS_VTS = WS_VT + (size_t)12 * 128 * SEQ * 2;
constexpr size_t WS_GA = WS_VTS + (size_t)48 * 128 * SKV * 2;
constexpr size_t WS_MIX = WS_GA + (size_t)NT * 768 * 2;
constexpr size_t WS_END = WS_MIX + (size_t)NT * 1024 * 2;

constexpr size_t O_YP = 0, O_KP = 33816576, O_VP = 58982400, O_PP = 84148224, O_KS = 84155904, O_VS = 84352512, O_PS = 84549120;

constexpr float QSCALE = 0.125f * 1.4426950408889634f;
constexpr float DN_ALPHA = 1.189207115002721f;

struct Params {
    const float* x_prompt; const float* x_sample; const float* cache_k; const float* cache_v; const float* state_pool;
    const float* w_in; const float* pool_w; const float* pool_b; const float* pool_scale;
    const float* lq1; const float* lk1; const float* lq2; const float* lk2; const float* subln_g;
    const float* w_out; const float* ln_g; const float* ln_b;
    float* out; unsigned char* ws;
};

extern __shared__ __attribute__((aligned(16))) unsigned char smem[];

DI unsigned pk(float lo, float hi) { f32x2 v = {lo, hi}; bf16x2_t b = __builtin_convertvector(v, bf16x2_t); return __builtin_bit_cast(unsigned, b); }
DI u16 bf1(float x) { __bf16 b = (__bf16)x; return __builtin_bit_cast(u16, b); }
DI float bf_lo(unsigned w) { return __uint_as_float(w << 16); }
DI float bf_hi(unsigned w) { return __uint_as_float(w & 0xffff0000u); }
DI float silu(float v) { return v / (1.0f + __expf(-v)); }
DI float wave_sum(float v) {
#pragma unroll
    for (int o = 32; o > 0; o >>= 1) v += __shfl_xor(v, o);
    return v;
}
typedef __amdgpu_buffer_rsrc_t rsrc_t;
DI rsrc_t mkrsrc(const void* p) { return __builtin_amdgcn_make_buffer_rsrc((void*)p, 0, 0x7fffffff, 0x00020000); }
DI u32x4 bload(rsrc_t rs, unsigned voff, unsigned soff) { return __builtin_amdgcn_raw_buffer_load_b128(rs, voff, soff, 0); }
#define LAUNDER(x) asm volatile("" : "+v"(x))
DI int perm16(int s) { return (s & ~12) | ((s & 4) << 1) | ((s & 8) >> 1); }

DI void phase0(const Params& p, int tid) {
    const size_t g0 = (size_t)blockIdx.x * 512 + tid, gs = (size_t)gridDim.x * 512;
    unsigned char* ws = p.ws;
    if (g0 == 0) { unsigned* c = (unsigned*)(ws + WS_CTRL); c[0] = 0u; c[1] = 0u; }
    {
        u16* xb = (u16*)(ws + WS_XB);
        for (size_t i = g0; i < (size_t)NT * 128; i += gs) {
            const size_t e = i * 8;
            const float* s = e < (size_t)NP * 1024 ? p.x_prompt + e : p.x_sample + (e - (size_t)NP * 1024);
            const f32x4 a = *(const f32x4*)s, b = *(const f32x4*)(s + 4);
            u32x4 w; w.x = pk(a.x, a.y); w.y = pk(a.z, a.w); w.z = pk(b.x, b.y); w.w = pk(b.z, b.w);
            *(u32x4*)(xb + e) = w;
        }
    }
    {
        u16* wt = (u16*)(ws + WS_WTIN);
        for (size_t i = g0; i < (size_t)INW * 128; i += gs) {
            const int n = (int)(i % INW), k8 = (int)(i / INW);
            const float* s = p.w_in + (size_t)k8 * 8 * INW + n;
            float v[8];
#pragma unroll
            for (int j = 0; j < 8; ++j) v[j] = s[(size_t)j * INW];
            u32x4 w; w.x = pk(v[0], v[1]); w.y = pk(v[2], v[3]); w.z = pk(v[4], v[5]); w.w = pk(v[6], v[7]);
            *(u32x4*)(wt + (size_t)n * 1024 + k8 * 8) = w;
        }
    }
    {
        u16* wt = (u16*)(ws + WS_WTOUT);
        for (size_t i = g0; i < (size_t)1024 * 128; i += gs) {
            const int n = (int)(i & 1023), k8 = (int)(i >> 10);
            const float* s = p.w_out + (size_t)k8 * 8 * 1024 + n;
            float v[8];
#pragma unroll
            for (int j = 0; j < 8; ++j) v[j] = s[(size_t)j * 1024];
            u32x4 w; w.x = pk(v[0], v[1]); w.y = pk(v[2], v[3]); w.z = pk(v[4], v[5]); w.w = pk(v[6], v[7]);
            *(u32x4*)(wt + (size_t)n * 1024 + k8 * 8) = w;
        }
    }
    {
        u16* pw = (u16*)(ws + WS_PWT);
        for (size_t i = g0; i < 16384; i += gs) {
            const int g = (int)(i >> 12), d = (int)((i >> 6) & 63), c = (int)(i & 63);
            pw[i] = bf1(p.pool_w[g * 4096 + c * 64 + d]);
        }
    }
    {
        u16* kb = (u16*)(ws + WS_KBS);
        for (size_t i = g0; i < (size_t)8 * 1024 * 96; i += gs) {
            const size_t e = i * 8; const int b = (int)(e / (1024 * 768)); const int rem = (int)(e % (1024 * 768));
            const float* s = p.cache_k + e;
            const f32x4 a = *(const f32x4*)s, c = *(const f32x4*)(s + 4);
            u32x4 w; w.x = pk(a.x, a.y); w.y = pk(a.z, a.w); w.z = pk(c.x, c.y); w.w = pk(c.z, c.w);
            *(u32x4*)(kb + (size_t)b * SKV * 768 + rem) = w;
        }
        for (size_t i = g0; i < (size_t)8 * 32 * 96; i += gs) {
            const int e = (int)i * 8; const int b = e / (32 * 768), rem = e % (32 * 768);
            u32x4 z = {0u, 0u, 0u, 0u};
            *(u32x4*)(kb + ((size_t)b * SKV + 1056) * 768 + rem) = z;
        }
    }
    {
        u16* vt = (u16*)(ws + WS_VTS);
        for (size_t i = g0; i < (size_t)48 * 64 * 128; i += gs) {
            const int d = (int)(i & 127), s16 = (int)((i >> 7) & 63), bh = (int)(i >> 13), b = bh / 6, h = bh % 6;
            const float* s = p.cache_v + ((size_t)(b * 1024 + s16 * 16) * 6 + h) * 128 + d;
            float v[16];
#pragma unroll
            for (int j = 0; j < 16; ++j) v[j] = s[(size_t)j * 768];
            u32x4 w0, w1;
            w0.x = pk(v[0], v[1]); w0.y = pk(v[2], v[3]); w0.z = pk(v[8], v[9]); w0.w = pk(v[10], v[11]);
            w1.x = pk(v[4], v[5]); w1.y = pk(v[6], v[7]); w1.z = pk(v[12], v[13]); w1.w = pk(v[14], v[15]);
            u16* dst = vt + ((size_t)bh * 128 + d) * SKV + s16 * 16;
            *(u32x4*)dst = w0; *(u32x4*)(dst + 8) = w1;
        }
        for (size_t i = g0; i < (size_t)48 * 128 * 4; i += gs) {
            u32x4 z = {0u, 0u, 0u, 0u};
            *(u32x4*)(vt + (i >> 2) * SKV + 1056 + (i & 3) * 8) = z;
        }
    }
}

template <int MB, int NB>
DI void mma_ktile(int aoff, int boff, int r, int hh, f32x16 (&acc)[MB][NB]) {
    const int sw = (r >> 1) & 7;
#pragma unroll
    for (int ks = 0; ks < 4; ++ks) {
        const int co = ((2 * ks + hh) ^ sw) << 4;
        bf16x8 a[MB], b[NB];
#pragma unroll
        for (int mb = 0; mb < MB; ++mb) a[mb] = *(const bf16x8*)(smem + aoff + (mb * 32 + r) * 128 + co);
#pragma unroll
        for (int nb = 0; nb < NB; ++nb) b[nb] = *(const bf16x8*)(smem + boff + (nb * 32 + r) * 128 + co);
#pragma unroll
        for (int mb = 0; mb < MB; ++mb)
#pragma unroll
            for (int nb = 0; nb < NB; ++nb) acc[mb][nb] = MFMA32(a[mb], b[nb], acc[mb][nb]);
    }
}

DI void phase1(const Params& p, int tid) {
    const int lane = tid & 63, w = tid >> 6, r = lane & 31, hh = lane >> 5, wm = w >> 2, wn = w & 3;
    unsigned char* ws = p.ws;
    const u16* xb = (const u16*)(ws + WS_XB); const u16* wt = (const u16*)(ws + WS_WTIN);
    const int lrow = tid >> 3, lch = tid & 7;
    const int ldst = lrow * 128 + ((lch ^ ((lrow >> 1) & 7)) << 4);
    const unsigned voff = (unsigned)(lrow * 2048 + lch * 16);
    for (int u = blockIdx.x; u < 129 * 14; u += gridDim.x) {
        const int pm = u / 14, pn = u % 14;
        const rsrc_t ag = mkrsrc((const unsigned char*)xb + (size_t)pm * 256 * 2048);
        const rsrc_t bg = mkrsrc((const unsigned char*)wt + (size_t)pn * 256 * 2048);
        f32x16 acc[4][2];
#pragma unroll
        for (int a = 0; a < 4; ++a)
#pragma unroll
            for (int b = 0; b < 2; ++b)
#pragma unroll
                for (int i = 0; i < 16; ++i) acc[a][b][i] = 0.f;
        u32x4 ra[4], rb[4];
#pragma unroll
        for (int i = 0; i < 4; ++i) { ra[i] = bload(ag, voff, i * 131072); rb[i] = bload(bg, voff, i * 131072); }
#pragma unroll
        for (int i = 0; i < 4; ++i) { *(u32x4*)(smem + ldst + i * 8192) = ra[i]; *(u32x4*)(smem + 32768 + ldst + i * 8192) = rb[i]; }
        __syncthreads();
        for (int kt = 0; kt < 16; ++kt) {
            const int cur = (kt & 1) * 65536, nxt = 65536 - cur;
            if (kt < 15) {
#pragma unroll
                for (int i = 0; i < 4; ++i) { ra[i] = bload(ag, voff, (kt + 1) * 128 + i * 131072); rb[i] = bload(bg, voff, (kt + 1) * 128 + i * 131072); }
            }
            mma_ktile<4, 2>(cur + wm * 16384, cur + 32768 + wn * 8192, r, hh, acc);
            if (kt < 15) {
#pragma unroll
                for (int i = 0; i < 4; ++i) { *(u32x4*)(smem + nxt + ldst + i * 8192) = ra[i]; *(u32x4*)(smem + nxt + 32768 + ldst + i * 8192) = rb[i]; }
            }
            __syncthreads();
        }
        int rbase = pm * 256 + wm * 128 + 4 * hh, ct0 = wn * 64 + r;
        LAUNDER(rbase); LAUNDER(ct0);
        const bool smp = (pm == 128);
        float* out = p.out;
        if (pn == 0) {
            float* U = (float*)(ws + WS_U);
#pragma unroll
            for (int mb = 0; mb < 4; ++mb)
#pragma unroll
                for (int i = 0; i < 16; ++i) {
                    const int R = rbase + mb * 32 + (i & 3) + 8 * (i >> 2);
#pragma unroll
                    for (int nb = 0; nb < 2; ++nb) {
                        const int col = ct0 + nb * 32; const float v = acc[mb][nb][i];
                        U[(size_t)R * 256 + col] = v;
                        if (!smp) { const int t = R & 16383; if (t >= 16369) out[O_PP + (size_t)((R >> 14) * 15 + (t - 16369)) * 256 + col] = v; }
                        else { const int rs = R - NP, t = rs & 31; if (t >= 17) out[O_PS + (size_t)((rs >> 5) * 15 + (t - 17)) * 256 + col] = v; }
                    }
                }
        } else if (pn == 1) {
            float* G = (float*)(ws + WS_GP);
#pragma unroll
            for (int mb = 0; mb < 4; ++mb)
#pragma unroll
                for (int i = 0; i < 16; ++i) {
                    const int R = rbase + mb * 32 + (i & 3) + 8 * (i >> 2);
#pragma unroll
                    for (int nb = 0; nb < 2; ++nb) G[(size_t)R * 256 + ct0 + nb * 32] = silu(acc[mb][nb][i]);
                }
        } else if (pn < 5) {
            u16* Q = (u16*)(ws + WS_QB) + (pn - 2) * 256 + ct0;
#pragma unroll
            for (int mb = 0; mb < 4; ++mb)
#pragma unroll
                for (int i = 0; i < 16; ++i) {
                    const int R = rbase + mb * 32 + (i & 3) + 8 * (i >> 2);
#pragma unroll
                    for (int nb = 0; nb < 2; ++nb) Q[(size_t)R * 768 + nb * 32] = bf1(acc[mb][nb][i] * QSCALE);
                }
        } else if (pn < 8) {
            const int cc0 = (pn - 5) * 256 + ct0;
            u16* KB = (u16*)(ws + WS_KB); u16* KS = (u16*)(ws + WS_KBS);
#pragma unroll
            for (int mb = 0; mb < 4; ++mb)
#pragma unroll
                for (int i = 0; i < 16; ++i) {
                    const int R = rbase + mb * 32 + (i & 3) + 8 * (i >> 2);
#pragma unroll
                    for (int nb = 0; nb < 2; ++nb) {
                        const int cc = cc0 + nb * 32; const float v = acc[mb][nb][i];
                        if (!smp) { out[O_KP + (size_t)R * 768 + cc] = v; KB[(size_t)R * 768 + cc] = bf1(v); }
                        else { const int rs = R - NP; out[O_KS + (size_t)rs * 768 + cc] = v; KS[((size_t)(rs >> 5) * SKV + 1024 + (rs & 31)) * 768 + cc] = bf1(v); }
                    }
                }
        } else if (pn < 11) {
            const int cc0 = (pn - 8) * 256 + ct0;
            u16* VT = (u16*)(ws + WS_VT); u16* VS = (u16*)(ws + WS_VTS);
#pragma unroll
            for (int mb = 0; mb < 4; ++mb)
#pragma unroll
                for (int nb = 0; nb < 2; ++nb) {
                    const int cc = cc0 + nb * 32, h = cc >> 7, d = cc & 127;
#pragma unroll
                    for (int j4 = 0; j4 < 4; ++j4) {
                        const int R0 = rbase + mb * 32 + 8 * j4;
                        const float v0 = acc[mb][nb][4 * j4], v1 = acc[mb][nb][4 * j4 + 1], v2 = acc[mb][nb][4 * j4 + 2], v3 = acc[mb][nb][4 * j4 + 3];
                        u32x2 pkd; pkd.x = pk(v0, v1); pkd.y = pk(v2, v3);
                        if (!smp) {
                            float* o = out + O_VP + (size_t)R0 * 768 + cc; o[0] = v0; o[768] = v1; o[1536] = v2; o[2304] = v3;
                            const int b = R0 >> 14, s = R0 & 16383;
                            *(u32x2*)(VT + ((size_t)(b * 6 + h) * 128 + d) * SEQ + perm16(s)) = pkd;
                        } else {
                            const int rs = R0 - NP;
                            float* o = out + O_VS + (size_t)rs * 768 + cc; o[0] = v0; o[768] = v1; o[1536] = v2; o[2304] = v3;
                            *(u32x2*)(VS + ((size_t)((rs >> 5) * 6 + h) * 128 + d) * SKV + 1024 + perm16(rs & 31)) = pkd;
                        }
                    }
                }
        } else {
            u16* G = (u16*)(ws + WS_GA) + (pn - 11) * 256 + ct0;
#pragma unroll
            for (int mb = 0; mb < 4; ++mb)
#pragma unroll
                for (int i = 0; i < 16; ++i) {
                    const int R = rbase + mb * 32 + (i & 3) + 8 * (i >> 2);
#pragma unroll
                    for (int nb = 0; nb < 2; ++nb) G[(size_t)R * 768 + nb * 32] = bf1(silu(acc[mb][nb][i]));
                }
        }
    }
}

DI void attn_unit(const Params& p, int tid, int qtok0, int h, const u16* kbase, const u16* vbase, int vstride, int ntiles, bool sample, float lam) {
    const int lane = tid & 63, w = tid >> 6, r = lane & 31, hh = lane >> 5, pair = w >> 1, cm = w & 1;
    unsigned char* ws = p.ws;
    int ntw = sample ? (pair == 0 ? ntiles : 0) : (ntiles - 1 + (pair >> 1));
    ntw = __builtin_amdgcn_readfirstlane(ntw);
    bf16x8 Qf[4];
    {
        const u16* qrow = (const u16*)(ws + WS_QB) + (size_t)(qtok0 + pair * 32 + r) * 768 + h * 128 + cm * 64 + hh * 8;
#pragma unroll
        for (int ks = 0; ks < 4; ++ks) {
            if (ntw > 0) Qf[ks] = *(const bf16x8*)(qrow + ks * 16);
            else Qf[ks] = (bf16x8){0, 0, 0, 0, 0, 0, 0, 0};
        }
    }
    f32x16 O[4];
#pragma unroll
    for (int d = 0; d < 4; ++d)
#pragma unroll
        for (int i = 0; i < 16; ++i) O[d][i] = 0.f;
    float m = -1e30f, l = 0.f;

    const int krow = tid >> 4, kch = tid & 15;
    const int kdst = krow * 256 + ((kch ^ (krow & 15)) << 4);
    const rsrc_t kg = mkrsrc(kbase);
    const unsigned kvo = (unsigned)(krow * 1536 + kch * 16);
    const int vrow = tid >> 3, vch = tid & 7;
    const int vdst = 16384 + vrow * 128 + ((vch ^ ((vrow >> 1) & 7)) << 4);
    const rsrc_t vg = mkrsrc(vbase);
    const unsigned vvo = (unsigned)(vrow * vstride * 2 + vch * 16);
    const unsigned vstep = 128u * (unsigned)vstride;
    u32x4 rk[2], rv[2];
#pragma unroll
    for (int i = 0; i < 2; ++i) { rk[i] = bload(kg, kvo, i * 49152); rv[i] = bload(vg, vvo, i * vstep); }
#pragma unroll
    for (int i = 0; i < 2; ++i) { *(u32x4*)(smem + kdst + i * 8192) = rk[i]; *(u32x4*)(smem + vdst + i * 8192) = rv[i]; }
    __syncthreads();
    const int ksw = r & 15, vsw = (r >> 1) & 7;
    for (int t = 0; t < ntiles; ++t) {
        const int cur = (t & 1) * 32768, nxt = 32768 - cur;
        if (t + 1 < ntiles) {
#pragma unroll
            for (int i = 0; i < 2; ++i) { rk[i] = bload(kg, kvo, ((t + 1) * 64 + i * 32) * 1536); rv[i] = bload(vg, vvo, (t + 1) * 128 + i * vstep); }
        }
        if (t < ntw) {
            f32x16 S0, S1;
#pragma unroll
            for (int i = 0; i < 16; ++i) { S0[i] = 0.f; S1[i] = 0.f; }
            const int kro = cur + r * 256;
#pragma unroll
            for (int ks = 0; ks < 4; ++ks) {
                const int co = ((cm * 8 + ks * 2 + hh) ^ ksw) << 4;
                const bf16x8 a0 = *(const bf16x8*)(smem + kro + co);
                const bf16x8 a1 = *(const bf16x8*)(smem + kro + 8192 + co);
                S0 = MFMA32(a0, Qf[ks], S0); S1 = MFMA32(a1, Qf[ks], S1);
            }
            if (sample && t == ntiles - 1) {
#pragma unroll
                for (int i = 0; i < 16; ++i) S1[i] = -INFINITY;
            }
            float mx = S0[0];
#pragma unroll
            for (int i = 1; i < 16; ++i) mx = fmaxf(mx, S0[i]);
#pragma unroll
            for (int i = 0; i < 16; ++i) mx = fmaxf(mx, S1[i]);
            mx = fmaxf(mx, __shfl_xor(mx, 32));
            if (__any(mx > m + 8.0f)) {
                const float mn = fmaxf(m, mx);
                const float alpha = __builtin_amdgcn_exp2f(m - mn);
#pragma unroll
                for (int d = 0; d < 4; ++d) O[d] *= alpha;
                l *= alpha; m = mn;
            }
            float ls = 0.f;
#pragma unroll
            for (int i = 0; i < 16; ++i) { S0[i] = __builtin_amdgcn_exp2f(S0[i] - m); S1[i] = __builtin_amdgcn_exp2f(S1[i] - m); ls += S0[i] + S1[i]; }
            l += ls;
            bf16x8 Pf[4];
            {
                u32x4 q;
                q.x = pk(S0[0], S0[1]); q.y = pk(S0[2], S0[3]); q.z = pk(S0[4], S0[5]); q.w = pk(S0[6], S0[7]); Pf[0] = __builtin_bit_cast(bf16x8, q);
                q.x = pk(S0[8], S0[9]); q.y = pk(S0[10], S0[11]); q.z = pk(S0[12], S0[13]); q.w = pk(S0[14], S0[15]); Pf[1] = __builtin_bit_cast(bf16x8, q);
                q.x = pk(S1[0], S1[1]); q.y = pk(S1[2], S1[3]); q.z = pk(S1[4], S1[5]); q.w = pk(S1[6], S1[7]); Pf[2] = __builtin_bit_cast(bf16x8, q);
                q.x = pk(S1[8], S1[9]); q.y = pk(S1[10], S1[11]); q.z = pk(S1[12], S1[13]); q.w = pk(S1[14], S1[15]); Pf[3] = __builtin_bit_cast(bf16x8, q);
            }
            const int vro = cur + 16384 + r * 128;
#pragma unroll
            for (int kk = 0; kk < 4; ++kk) {
                const int co = ((2 * kk + hh) ^ vsw) << 4;
#pragma unroll
                for (int d = 0; d < 4; ++d) {
                    const bf16x8 v = *(const bf16x8*)(smem + vro + d * 4096 + co);
                    O[d] = MFMA32(v, Pf[kk], O[d]);
                }
            }
        }
        if (t + 1 < ntiles) {
#pragma unroll
            for (int i = 0; i < 2; ++i) { *(u32x4*)(smem + nxt + kdst + i * 8192) = rk[i]; *(u32x4*)(smem + nxt + vdst + i * 8192) = rv[i]; }
        }
        __syncthreads();
    }
    const float lt = l + __shfl_xor(l, 32);
    const float inv = 1.0f / lt;
    int xo = XOFF + pair * 16384 + lane * 4;
    LAUNDER(xo);
    if (cm == 1 && ntw > 0) {
        const float sc = lam * inv;
#pragma unroll
        for (int d = 0; d < 4; ++d)
#pragma unroll
            for (int i = 0; i < 16; ++i) *(float*)(smem + xo + (d * 16 + i) * 256) = O[d][i] * sc;
    }
    __syncthreads();
    if (cm == 0 && ntw > 0) {
        float ss = 0.f;
#pragma unroll
        for (int d = 0; d < 4; ++d)
#pragma unroll
            for (int i = 0; i < 16; ++i) { const float v = O[d][i] * inv - *(const float*)(smem + xo + (d * 16 + i) * 256); O[d][i] = v; ss += v * v; }
        asm volatile("" ::: "memory");
        ss += __shfl_xor(ss, 32);
        const float rstd = rsqrtf(ss * (1.0f / 128.0f) + 1e-5f) * 0.8f;
        int tok = qtok0 + pair * 32 + r, hh4 = 4 * hh;
        LAUNDER(tok); LAUNDER(hh4);
        const u16* ga = (const u16*)(ws + WS_GA) + (size_t)tok * 768 + h * 128;
        u16* mo = (u16*)(ws + WS_MIX) + (size_t)tok * 1024 + 256 + h * 128;
#pragma unroll
        for (int d = 0; d < 4; ++d)
#pragma unroll
            for (int j4 = 0; j4 < 4; ++j4) {
                const int d0 = d * 32 + 8 * j4 + hh4;
                const u32x2 g = *(const u32x2*)(ga + d0);
                const f32x4 sg = *(const f32x4*)(p.subln_g + d0);
                const float v0 = O[d][4 * j4] * rstd * sg.x * bf_lo(g.x), v1 = O[d][4 * j4 + 1] * rstd * sg.y * bf_hi(g.x);
                const float v2 = O[d][4 * j4 + 2] * rstd * sg.z * bf_lo(g.y), v3 = O[d][4 * j4 + 3] * rstd * sg.w * bf_hi(g.y);
                u32x2 o; o.x = pk(v0, v1); o.y = pk(v2, v3);
                *(u32x2*)(mo + d0) = o;
                if (j4 & 1) asm volatile("" ::: "memory");
            }
    }
}

DI void pool_unit(const Params& p, int tid, int pu) {
    const int lane = tid & 63, w = tid >> 6, r = lane & 31, hh = lane >> 5;
    unsigned char* ws = p.ws;
    const float* U = (const float*)(ws + WS_U);
    const int tok0 = pu * 32; const bool smp = tok0 >= NP;
    float* E = (float*)smem;
    u16* PA = (u16*)(smem + 49152);
#pragma unroll 1
    for (int i = tid; i < 47 * 64; i += 512) {
        const int row = i >> 6, c4 = (i & 63) * 4; f32x4 v;
        if (row < 15) {
            if (smp) v = *(const f32x4*)(p.state_pool + ((size_t)((tok0 - NP) >> 5) * 15 + row) * 256 + c4);
            else if ((tok0 & 16383) == 0) v = (f32x4){0.f, 0.f, 0.f, 0.f};
            else v = *(const f32x4*)(U + (size_t)(tok0 - 15 + row) * 256 + c4);
        } else v = *(const f32x4*)(U + (size_t)(tok0 + row - 15) * 256 + c4);
        *(f32x4*)(E + row * 256 + c4) = v;
    }
    __syncthreads();
    {
        const int c = tid & 255, th = tid >> 8, g = c >> 6, wdw = 2 << g, tin0 = tok0 & 16383;
#pragma unroll 1
        for (int tt = 0; tt < 16; ++tt) {
            const int t = th * 16 + tt; float s = 0.f;
#pragma unroll 2
            for (int i = 0; i < wdw; ++i) s += E[(15 + t - i) * 256 + c];
            const int cnt = smp ? wdw : min(wdw, tin0 + t + 1);
            const float pooled = s / (float)cnt - E[(15 + t) * 256 + c];
            PA[t * 264 + c] = bf1(pooled);
        }
    }
    __syncthreads();
    {
        const int g = w >> 1, nb = w & 1;
        const u16* pw = (const u16*)(ws + WS_PWT) + (size_t)(g * 64 + nb * 32 + r) * 64 + hh * 8;
        f32x16 acc;
#pragma unroll
        for (int i = 0; i < 16; ++i) acc[i] = 0.f;
#pragma unroll
        for (int ks = 0; ks < 4; ++ks) {
            const bf16x8 a = *(const bf16x8*)(PA + r * 264 + g * 64 + ks * 16 + hh * 8);
            const bf16x8 b = *(const bf16x8*)(pw + ks * 16);
            acc = MFMA32(a, b, acc);
        }
        const int col = g * 64 + nb * 32 + r; const float pb = p.pool_b[col], ps = p.pool_scale[col];
        const float* G = (const float*)(ws + WS_GP); u16* mo = (u16*)(ws + WS_MIX);
#pragma unroll
        for (int i = 0; i < 16; ++i) {
            const int tok = tok0 + (i & 3) + 8 * (i >> 2) + 4 * hh;
            mo[(size_t)tok * 1024 + col] = bf1((acc[i] + pb) * ps * G[(size_t)tok * 256 + col]);
        }
    }
    __syncthreads();
}

DI void phase2(const Params& p, int tid) {
    unsigned char* ws = p.ws;
    const int lane = tid & 63;
    const float sa = wave_sum(p.lq1[lane] * p.lk1[lane]), sb = wave_sum(p.lq2[lane] * p.lk2[lane]);
    const float lam = __expf(sa) - __expf(sb) + 0.2f;
    const u16* KB = (const u16*)(ws + WS_KB); const u16* VT = (const u16*)(ws + WS_VT);
    for (int pi = blockIdx.x; pi < 768; pi += gridDim.x) {
        int bh, j;
        if (gridDim.x == 256) { const int xcd = blockIdx.x & 7, slot = blockIdx.x >> 3, rnd = pi >> 8; bh = rnd * 4 + (xcd & 3); j = slot + 32 * (xcd >> 2); }
        else { bh = pi >> 6; j = pi & 63; }
        const int b = bh / 6, h = bh % 6;
        for (int half = 0; half < 2; ++half) {
            const int qb = half == 0 ? 127 - j : j;
            attn_unit(p, tid, b * SEQ + qb * 128, h, KB + (size_t)b * SEQ * 768 + h * 128, VT + (size_t)bh * 128 * SEQ, SEQ, 2 * qb + 2, false, lam);
        }
    }
    unsigned* ctrl = (unsigned*)(ws + WS_CTRL);
    const u16* KS = (const u16*)(ws + WS_KBS); const u16* VS = (const u16*)(ws + WS_VTS);
    for (;;) {
        if (tid == 0) *(volatile int*)(smem + LDS_SLOT) = (int)atomicAdd(ctrl, 1u);
        __syncthreads();
        const int u = *(volatile int*)(smem + LDS_SLOT);
        __syncthreads();
        if (u >= 48 + 1032) break;
        if (u < 48) {
            const int b = u / 6, h = u % 6;
            attn_unit(p, tid, NP + b * 32, h, KS + (size_t)b * SKV * 768 + h * 128, VS + (size_t)u * 128 * SKV, SKV, 17, true, lam);
        } else pool_unit(p, tid, u - 48);
    }
}

constexpr int STG3 = 73728;
template <int HF>
DI void p3_half(f32x16 (&acc)[2][2], u32x4& ra, u32x4 (&rb)[8], rsrc_t ag, rsrc_t bg, unsigned voff, int ldst, int w, int r, int hh) {
#pragma unroll 2
    for (int kt = 0; kt < 16; ++kt) {
        const int cur = (kt & 1) * STG3, nxt = STG3 - cur;
        const bool more = (HF == 0) || (kt < 15);
        if (more) {
            const int n = HF * 16 + kt + 1, nkt = n & 15, nhf = n >> 4;
            ra = bload(ag, voff, nkt * 128);
#pragma unroll
            for (int i = 0; i < 8; ++i) rb[i] = bload(bg, voff, (nhf * 512 + i * 64) * 2048 + nkt * 128);
        }
        mma_ktile<2, 2>(cur, cur + 8192 + w * 8192, r, hh, acc);
        if (more) {
            *(u32x4*)(smem + nxt + ldst) = ra;
#pragma unroll
            for (int i = 0; i < 8; ++i) *(u32x4*)(smem + nxt + 8192 + ldst + i * 8192) = rb[i];
        }
        __syncthreads();
    }
}

DI void phase3(const Params& p, int tid) {
    const int lane = tid & 63, w = tid >> 6, r = lane & 31, hh = lane >> 5;
    unsigned char* ws = p.ws;
    const u16* mix = (const u16*)(ws + WS_MIX); const u16* wt = (const u16*)(ws + WS_WTOUT);
    const int lrow = tid >> 3, lch = tid & 7;
    const int ldst = lrow * 128 + ((lch ^ ((lrow >> 1) & 7)) << 4);
    const unsigned voff = (unsigned)(lrow * 2048 + lch * 16);
    for (int um = blockIdx.x; um < NT / 64; um += gridDim.x) {
        const int row0 = um * 64;
        const rsrc_t ag = mkrsrc((const unsigned char*)mix + (size_t)row0 * 2048);
        const rsrc_t bg = mkrsrc(wt);
        f32x16 acc0[2][2], acc1[2][2];
#pragma unroll
        for (int a = 0; a < 2; ++a)
#pragma unroll
            for (int b = 0; b < 2; ++b)
#pragma unroll
                for (int i = 0; i < 16; ++i) { acc0[a][b][i] = 0.f; acc1[a][b][i] = 0.f; }
        u32x4 ra, rb[8];
        ra = bload(ag, voff, 0);
#pragma unroll
        for (int i = 0; i < 8; ++i) rb[i] = bload(bg, voff, i * 131072);
        *(u32x4*)(smem + ldst) = ra;
#pragma unroll
        for (int i = 0; i < 8; ++i) *(u32x4*)(smem + 8192 + ldst + i * 8192) = rb[i];
        __syncthreads();
        p3_half<0>(acc0, ra, rb, ag, bg, voff, ldst, w, r, hh);
        p3_half<1>(acc1, ra, rb, ag, bg, voff, ldst, w, r, hh);
        float* T = (float*)smem;
#pragma unroll
        for (int mbs = 0; mbs < 2; ++mbs) {
            int tb = (4 * hh * 1024 + w * 64 + r) * 4;
            LAUNDER(tb);
#pragma unroll
            for (int nb = 0; nb < 2; ++nb)
#pragma unroll
                for (int i = 0; i < 16; ++i) {
                    const int o = ((i & 3) + 8 * (i >> 2)) * 4096 + nb * 128;
                    *(float*)(smem + tb + o) = acc0[mbs][nb][i]; *(float*)(smem + tb + o + 2048) = acc1[mbs][nb][i];
                }
            __syncthreads();
#pragma unroll 1
            for (int rr = 0; rr < 4; ++rr) {
                int rl = w * 4 + rr; LAUNDER(rl);
                const int R = row0 + mbs * 32 + rl;
                const float* xr = R < NP ? p.x_prompt + (size_t)R * 1024 : p.x_sample + (size_t)(R - NP) * 1024;
                f32x4 z[4]; float s = 0.f;
#pragma unroll
                for (int j = 0; j < 4; ++j) {
                    const int col = j * 256 + lane * 4;
                    const f32x4 o = *(const f32x4*)(T + rl * 1024 + col), xv = *(const f32x4*)(xr + col);
                    z[j] = xv * DN_ALPHA + o; s += (z[j].x + z[j].y) + (z[j].z + z[j].w);
                }
                const float mu = wave_sum(s) * (1.0f / 1024.0f);
                float q = 0.f;
#pragma unroll
                for (int j = 0; j < 4; ++j) { const f32x4 d = z[j] - mu; q += (d.x * d.x + d.y * d.y) + (d.z * d.z + d.w * d.w); }
                const float rstd = rsqrtf(wave_sum(q) * (1.0f / 1024.0f) + 1e-5f);
                float* yo = p.out + O_YP + (size_t)R * 1024;
#pragma unroll
                for (int j = 0; j < 4; ++j) {
                    const int col = j * 256 + lane * 4;
                    const f32x4 g = *(const f32x4*)(p.ln_g + col), bb = *(const f32x4*)(p.ln_b + col);
                    *(f32x4*)(yo + col) = (z[j] - mu) * rstd * g + bb;
                }
            }
            __syncthreads();
        }
    }
}

__global__ void __launch_bounds__(512) fwd_kernel(Params p) {
    cg::grid_group grid = cg::this_grid();
    const int tid = threadIdx.x;
    phase0(p, tid);
    grid.sync();
    phase1(p, tid);
    grid.sync();
    phase2(p, tid);
    grid.sync();
    phase3(p, tid);
}

extern "C" void kernel_launch(void* const* d_in, const int* in_sizes, int n_in, void* d_out, int out_size, void* d_ws, size_t ws_size, hipStream_t stream) {
    static int grid = 0;
    if (grid == 0) {
        if (n_in != 17 || ws_size < WS_END) { fprintf(stderr, "kernel_launch: unexpected n_in %d / ws_size %zu (need %zu)\n", n_in, ws_size, (size_t)WS_END); grid = -1; return; }
        int dev = 0, cus = 0, per_cu = 0;
        hipGetDevice(&dev);
        hipDeviceGetAttribute(&cus, hipDeviceAttributeMultiprocessorCount, dev);
        if (hipFuncSetAttribute((const void*)fwd_kernel, hipFuncAttributeMaxDynamicSharedMemorySize, LDS_BYTES) != hipSuccess) { fprintf(stderr, "kernel_launch: hipFuncSetAttribute failed\n"); grid = -1; return; }
        if (hipOccupancyMaxActiveBlocksPerMultiprocessor(&per_cu, (const void*)fwd_kernel, 512, LDS_BYTES) != hipSuccess || per_cu < 1) { fprintf(stderr, "kernel_launch: occupancy query gave %d\n", per_cu); per_cu = 1; }
        (void)hipGetLastError();
        grid = cus * per_cu;
        fprintf(stderr, "kernel_launch: grid %d (cus %d x %d)\n", grid, cus, per_cu);
    }
    if (grid < 0) return;
    Params p{};
    p.x_prompt = (const float*)d_in[0]; p.x_sample = (const float*)d_in[1]; p.cache_k = (const float*)d_in[2]; p.cache_v = (const float*)d_in[3]; p.state_pool = (const float*)d_in[4];
    p.w_in = (const float*)d_in[5]; p.pool_w = (const float*)d_in[6]; p.pool_b = (const float*)d_in[7]; p.pool_scale = (const float*)d_in[8];
    p.lq1 = (const float*)d_in[9]; p.lk1 = (const float*)d_in[10]; p.lq2 = (const float*)d_in[11]; p.lk2 = (const float*)d_in[12]; p.subln_g = (const float*)d_in[13];
    p.w_out = (const float*)d_in[14]; p.ln_g = (const float*)d_in[15]; p.ln_b = (const float*)d_in[16];
    p.out = (float*)d_out; p.ws = (unsigned char*)d_ws;
    void* args[] = {&p};
    hipError_t e = hipLaunchCooperativeKernel((const void*)fwd_kernel, dim3(grid), dim3(512), args, LDS_BYTES, stream);
    if (e != hipSuccess) fprintf(stderr, "kernel_launch: cooperative launch failed: %s (grid %d)\n", hipGetErrorString(e), grid);
}
```

```cpp
#include <hip/hip_runtime.h>
#include <hip/hip_cooperative_groups.h>
#include <cstdio>
#include <cstdint>
namespace cg = cooperative_groups;

typedef short bf16x8 __attribute__((ext_vector_type(8)));
typedef float f32x16 __attribute__((ext_vector_type(16)));
typedef float f32x4 __attribute__((ext_vector_type(4)));
typedef float f32x2 __attribute__((ext_vector_type(2)));
typedef __bf16 bf16x2_t __attribute__((ext_vector_type(2)));
typedef unsigned u32x4 __attribute__((ext_vector_type(4)));
typedef unsigned u32x2 __attribute__((ext_vector_type(2)));
typedef unsigned short u16;

#define MFMA32(a, b, c) __builtin_amdgcn_mfma_f32_32x32x16_bf16((a), (b), (c), 0, 0, 0)
#define DI __device__ __forceinline__

constexpr int NP = 32768, NS = 256, NT = NP + NS;
constexpr int INW = 3584, SEQ = 16384, SKV = 1088;
constexpr int LDS_BYTES = 147456;
constexpr int LDS_SLOT = 147440;
constexpr int XOFF = 73728;

constexpr size_t WS_CTRL = 0;
constexpr size_t WS_XB = 4096;
constexpr size_t WS_WTIN = WS_XB + (size_t)NT * 1024 * 2;
constexpr size_t WS_WTOUT = WS_WTIN + (size_t)INW * 1024 * 2;
constexpr size_t WS_PWT = WS_WTOUT + (size_t)1024 * 1024 * 2;
constexpr size_t WS_U = WS_PWT + 32768;
constexpr size_t WS_GP = WS_U + (size_t)NT * 256 * 4;
constexpr size_t WS_QB = WS_GP + (size_t)NT * 256 * 4;
constexpr size_t WS_KB = WS_QB + (size_t)NT * 768 * 2;
constexpr size_t WS_KBS = WS_KB + (size_t)NP * 768 * 2;
constexpr size_t WS_VT = WS_KBS + (size_t)8 * SKV * 768 * 2;
constexpr size_t WS_VTS = WS_VT + (size_t)12 * 128 * SEQ * 2;
constexpr size_t WS_GA = WS_VTS + (size_t)48 * 128 * SKV * 2;
constexpr size_t WS_MIX = WS_GA + (size_t)NT * 768 * 2;
constexpr size_t WS_ST = WS_MIX + (size_t)NT * 1024 * 2;
constexpr size_t WS_END = WS_ST + (size_t)NT * 16 * 8;

constexpr size_t O_YP = 0, O_KP = 33816576, O_VP = 58982400, O_PP = 84148224, O_KS = 84155904, O_VS = 84352512, O_PS = 84549120;

constexpr float QSCALE = 0.125f * 1.4426950408889634f;
constexpr float DN_ALPHA = 1.189207115002721f;

struct Params {
    const float* x_prompt; const float* x_sample; const float* cache_k; const float* cache_v; const float* state_pool;
    const float* w_in; const float* pool_w; const float* pool_b; const float* pool_scale;
    const float* lq1; const float* lk1; const float* lq2; const float* lk2; const float* subln_g;
    const float* w_out; const float* ln_g; const float* ln_b;
    float* out; unsigned char* ws;
};

extern __shared__ __attribute__((aligned(16))) unsigned char smem[];

DI unsigned pk(float lo, float hi) { f32x2 v = {lo, hi}; bf16x2_t b = __builtin_convertvector(v, bf16x2_t); return __builtin_bit_cast(unsigned, b); }
DI u16 bf1(float x) { __bf16 b = (__bf16)x; return __builtin_bit_cast(u16, b); }
DI float bf_lo(unsigned w) { return __uint_as_float(w << 16); }
DI float bf_hi(unsigned w) { return __uint_as_float(w & 0xffff0000u); }
DI float silu(float v) { return v / (1.0f + __expf(-v)); }
DI float wave_sum(float v) {
#pragma unroll
    for (int o = 32; o > 0; o >>= 1) v += __shfl_xor(v, o);
    return v;
}
typedef __amdgpu_buffer_rsrc_t rsrc_t;
DI rsrc_t mkrsrc(const void* p) { return __builtin_amdgcn_make_buffer_rsrc((void*)p, 0, 0x7fffffff, 0x00020000); }
DI u32x4 bload(rsrc_t rs, unsigned voff, unsigned soff) { return __builtin_amdgcn_raw_buffer_load_b128(rs, voff, soff, 0); }
#define LAUNDER(x) asm volatile("" : "+v"(x))
DI int perm16(int s) { return (s & ~12) | ((s & 4) << 1) | ((s & 8) >> 1); }

DI void grid_barrier(unsigned* cnt) {
    __syncthreads();
    if (threadIdx.x == 0) {
        __builtin_amdgcn_fence(__ATOMIC_RELEASE, "agent");
        __hip_atomic_fetch_add(cnt, 1u, __ATOMIC_RELAXED, __HIP_MEMORY_SCOPE_AGENT);
        const unsigned want = gridDim.x;
        while (__hip_atomic_load(cnt, __ATOMIC_RELAXED, __HIP_MEMORY_SCOPE_AGENT) < want) __builtin_amdgcn_s_sleep(2);
        __builtin_amdgcn_fence(__ATOMIC_ACQUIRE, "agent");
    }
    __syncthreads();
}
DI void phase0(const Params& p, int tid) {
    const size_t g0 = (size_t)blockIdx.x * 512 + tid, gs = (size_t)gridDim.x * 512;
    unsigned char* ws = p.ws;
    {
        u16* xb = (u16*)(ws + WS_XB);
        const size_t N = (size_t)NT * 128;
        for (size_t i0 = g0; i0 < N; i0 += 4 * gs) {
            f32x4 a[4], b[4];
#pragma unroll
            for (int u = 0; u < 4; ++u) {
                const size_t i = i0 + u * gs;
                if (i < N) {
                    const size_t e = i * 8;
                    const float* s = e < (size_t)NP * 1024 ? p.x_prompt + e : p.x_sample + (e - (size_t)NP * 1024);
                    a[u] = *(const f32x4*)s; b[u] = *(const f32x4*)(s + 4);
                }
            }
#pragma unroll
            for (int u = 0; u < 4; ++u) {
                const size_t i = i0 + u * gs;
                if (i < N) {
                    u32x4 w; w.x = pk(a[u].x, a[u].y); w.y = pk(a[u].z, a[u].w); w.z = pk(b[u].x, b[u].y); w.w = pk(b[u].z, b[u].w);
                    *(u32x4*)(xb + i * 8) = w;
                }
            }
        }
    }
    {
        u16* wt = (u16*)(ws + WS_WTIN);
        for (size_t i = g0; i < (size_t)INW * 128; i += gs) {
            const int n = (int)(i % INW), k8 = (int)(i / INW);
            const float* s = p.w_in + (size_t)k8 * 8 * INW + n;
            float v[8];
#pragma unroll
            for (int j = 0; j < 8; ++j) v[j] = s[(size_t)j * INW];
            u32x4 w; w.x = pk(v[0], v[1]); w.y = pk(v[2], v[3]); w.z = pk(v[4], v[5]); w.w = pk(v[6], v[7]);
            *(u32x4*)(wt + (size_t)n * 1024 + k8 * 8) = w;
        }
    }
    {
        u16* wt = (u16*)(ws + WS_WTOUT);
        for (size_t i = g0; i < (size_t)1024 * 128; i += gs) {
            const int n = (int)(i & 1023), k8 = (int)(i >> 10);
            const float* s = p.w_out + (size_t)k8 * 8 * 1024 + n;
            float v[8];
#pragma unroll
            for (int j = 0; j < 8; ++j) v[j] = s[(size_t)j * 1024];
            u32x4 w; w.x = pk(v[0], v[1]); w.y = pk(v[2], v[3]); w.z = pk(v[4], v[5]); w.w = pk(v[6], v[7]);
            *(u32x4*)(wt + (size_t)n * 1024 + k8 * 8) = w;
        }
    }
    {
        u16* pw = (u16*)(ws + WS_PWT);
        for (size_t i = g0; i < 16384; i += gs) {
            const int g = (int)(i >> 12), d = (int)((i >> 6) & 63), c = (int)(i & 63);
            pw[i] = bf1(p.pool_w[g * 4096 + c * 64 + d]);
        }
    }
    {
        u16* kb = (u16*)(ws + WS_KBS);
        const size_t NK = (size_t)8 * 1024 * 96;
        for (size_t i0 = g0; i0 < NK; i0 += 4 * gs) {
            f32x4 a[4], c[4];
#pragma unroll
            for (int u = 0; u < 4; ++u) { const size_t i = i0 + u * gs; if (i < NK) { const float* s = p.cache_k + i * 8; a[u] = *(const f32x4*)s; c[u] = *(const f32x4*)(s + 4); } }
#pragma unroll
            for (int u = 0; u < 4; ++u) {
                const size_t i = i0 + u * gs;
                if (i < NK) {
                    const size_t e = i * 8; const int b = (int)(e / (1024 * 768)); const int rem = (int)(e % (1024 * 768));
                    u32x4 w; w.x = pk(a[u].x, a[u].y); w.y = pk(a[u].z, a[u].w); w.z = pk(c[u].x, c[u].y); w.w = pk(c[u].z, c[u].w);
                    *(u32x4*)(kb + (size_t)b * SKV * 768 + rem) = w;
                }
            }
        }
        for (size_t i = g0; i < (size_t)8 * 32 * 96; i += gs) {
            const int e = (int)i * 8; const int b = e / (32 * 768), rem = e % (32 * 768);
            u32x4 z = {0u, 0u, 0u, 0u};
            *(u32x4*)(kb + ((size_t)b * SKV + 1056) * 768 + rem) = z;
        }
    }
    {
        u16* vt = (u16*)(ws + WS_VTS);
        for (size_t i = g0; i < (size_t)48 * 64 * 128; i += gs) {
            const int d = (int)(i & 127), s16 = (int)((i >> 7) & 63), bh = (int)(i >> 13), b = bh / 6, h = bh % 6;
            const float* s = p.cache_v + ((size_t)(b * 1024 + s16 * 16) * 6 + h) * 128 + d;
            float v[16];
#pragma unroll
            for (int j = 0; j < 16; ++j) v[j] = s[(size_t)j * 768];
            u32x4 w0, w1;
            w0.x = pk(v[0], v[1]); w0.y = pk(v[2], v[3]); w0.z = pk(v[8], v[9]); w0.w = pk(v[10], v[11]);
            w1.x = pk(v[4], v[5]); w1.y = pk(v[6], v[7]); w1.z = pk(v[12], v[13]); w1.w = pk(v[14], v[15]);
            u16* dst = vt + ((size_t)bh * 128 + d) * SKV + s16 * 16;
            *(u32x4*)dst = w0; *(u32x4*)(dst + 8) = w1;
        }
        for (size_t i = g0; i < (size_t)48 * 128 * 4; i += gs) {
            u32x4 z = {0u, 0u, 0u, 0u};
            *(u32x4*)(vt + (i >> 2) * SKV + 1056 + (i & 3) * 8) = z;
        }
    }
}

template <int MB, int NB, bool FENCE = false>
DI void mma_ktile(int aoff, int boff, int r, int hh, f32x16 (&acc)[MB][NB]) {
    const int sw = (r >> 1) & 7;
#pragma unroll
    for (int ks = 0; ks < 4; ++ks) {
        if (FENCE && (ks > 0)) __builtin_amdgcn_sched_barrier(0);
        const int co = ((2 * ks + hh) ^ sw) << 4;
        bf16x8 a[MB], b[NB];
#pragma unroll
        for (int mb = 0; mb < MB; ++mb) a[mb] = *(const bf16x8*)(smem + aoff + (mb * 32 + r) * 128 + co);
#pragma unroll
        for (int nb = 0; nb < NB; ++nb) b[nb] = *(const bf16x8*)(smem + boff + (nb * 32 + r) * 128 + co);
#pragma unroll
        for (int mb = 0; mb < MB; ++mb)
#pragma unroll
            for (int nb = 0; nb < NB; ++nb) acc[mb][nb] = MFMA32(a[mb], b[nb], acc[mb][nb]);
    }
}

namespace pg8 {
#define PG8_LAS __attribute__((address_space(3)))
typedef unsigned short bf16_t;
typedef short bf16x8 __attribute__((ext_vector_type(8)));
typedef float f32x4 __attribute__((ext_vector_type(4)));
typedef unsigned u32x4 __attribute__((ext_vector_type(4)));
constexpr int BM = 256, BK = 64, HALF = 128, HTB = HALF * BK * 2  , STAGE_BYTES = 8 * HTB, NXCD = 8, WGM = 8;

__host__ __device__ __forceinline__ int lds_byte(int r, int c) { const int st = (r >> 4) * 2 + (c >> 5), rr = r & 15, cc = c & 31, ob = rr * 64 + cc * 2; return st * 1024 + (ob ^ (((ob >> 9) & 1) << 5)); }
__host__ __device__ __forceinline__ void stage_rc(int b, int& R, int& C) { const int st = b / 1024, sb = b % 1024, swz = sb ^ (((sb >> 9) & 1) << 5); R = (st >> 1) * 16 + swz / 64; C = (st & 1) * 32 + (swz % 64) / 2; }
__host__ __device__ __forceinline__ int perm32(int rho) { const int n = rho >> 4, i = rho & 15; return 8 * (i >> 2) + 4 * n + (i & 3); }

struct Unit { int pm, pn; };
struct Gemm { const bf16_t* A; const bf16_t* Bt; int M, N, K; };

struct StaticOrder {
    int nM, nN, nwg, G, c;
    __host__ __device__ void init(int M, int N, int G_, int c_) { nM = M / BM; nN = N / BM; nwg = nM * nN; G = G_; c = c_; }
    __host__ __device__ bool next(int i, Unit& u) const {
        const long L = (long)i * G + c; if (L >= nwg) return false;
        int wgid = (int)L; { const int q = nwg / NXCD, r = nwg % NXCD, xcd = wgid % NXCD, off = wgid / NXCD; wgid = (xcd < r ? xcd * (q + 1) : r * (q + 1) + (xcd - r) * q) + off; }
        const int nig = WGM * nN, gid = wgid / nig, fm = gid * WGM, gsz = (nM - fm) < WGM ? (nM - fm) : WGM;
        u.pm = fm + ((wgid % nig) % gsz); u.pn = (wgid % nig) / gsz; return true;
    }
    __device__ __forceinline__ void a_ready(const Unit&) const {}
    __device__ __forceinline__ void done(const Unit&) const {}
};

typedef float f32x2 __attribute__((ext_vector_type(2)));
template <class Epi, class Sched, bool ALIGN_EPI = false, bool SP2 = false>
__device__ __forceinline__ void gemm_phase(PG8_LAS unsigned char* lds, const Gemm g, const Sched& S, const Epi& E) {
    const int tid = threadIdx.x, wid = __builtin_amdgcn_readfirstlane(tid >> 6), lane = tid & 63, wr = wid >> 2, wc = wid & 3, fr = lane & 15, fq = lane >> 4;
    const int K = g.K, nt = K / BK;
    unsigned voffA[2], voffB[2];
#pragma unroll
    for (int i = 0; i < 2; ++i) { int R, C; stage_rc(tid * 16 + i * 8192, R, C); const int Rb = Epi::PERM ? ((R & ~31) + perm32(R & 31)) : R;
        voffA[i] = (unsigned)(R * K + C) * 2u; voffB[i] = (unsigned)(Rb * K + C) * 2u; }
    const size_t kstep = (size_t)(BK * 2);
    const size_t hstep = (size_t)HALF * K * 2;
    const size_t tstep = 2 * hstep;
    const unsigned ldsw = (unsigned)wid * 1024u;
    const int aoff = lds_byte(wr * 64 + fr, fq * 8), boff = lds_byte(wc * 32 + fr, fq * 8);
#define PG8_SA(b, h) (((b) * 2 + (h)) * HTB)
#define PG8_SB(b, h) ((4 + (b) * 2 + (h)) * HTB)
#define PG8_STAGE(bufoff, gbase, voff) do { _Pragma("unroll") for (int _i = 0; _i < 2; ++_i) \
        __builtin_amdgcn_global_load_lds((const unsigned*)((const char*)(gbase) + (voff)[_i]), (PG8_LAS unsigned*)(lds + (bufoff) + ldsw + _i * 8192), 16, 0, 0); } while (0)
#define PG8_LDA(dst, b, h) do { _Pragma("unroll") for (int m = 0; m < 4; ++m) _Pragma("unroll") for (int k = 0; k < 2; ++k) dst[m][k] = *(const PG8_LAS bf16x8*)(lds + PG8_SA(b, h) + aoff + m * 2048 + k * 1024); } while (0)
#define PG8_LDB(dst, b, h) do { _Pragma("unroll") for (int n = 0; n < 2; ++n) _Pragma("unroll") for (int k = 0; k < 2; ++k) dst[n][k] = *(const PG8_LAS bf16x8*)(lds + PG8_SB(b, h) + boff + n * 2048 + k * 1024); } while (0)
#define PG8_MMA(ai, bj, At, Bt) do { __builtin_amdgcn_s_setprio(1); _Pragma("unroll") for (int m = 0; m < 4; ++m) _Pragma("unroll") for (int n = 0; n < 2; ++n) _Pragma("unroll") for (int k = 0; k < 2; ++k) \
        acc[ai][bj][m][n] = __builtin_amdgcn_mfma_f32_16x16x32_bf16(Bt[n][k], At[m][k], acc[ai][bj][m][n], 0, 0, 0); __builtin_amdgcn_s_setprio(0); } while (0)
#define PG8_WAIT_V(n) asm volatile("s_waitcnt vmcnt(" #n ")" ::: "memory")
#define PG8_WAIT_L(n) asm volatile("s_waitcnt lgkmcnt(" #n ")" ::: "memory")
#define PG8_BAR __builtin_amdgcn_s_barrier()
#define PG8_SCHED __builtin_amdgcn_sched_barrier(0)
    Unit cur, nxt; int ui = 0;
    if (!S.next(0, cur)) return;
    f32x4 acc[2][2][4][2];
#pragma unroll
    for (int a = 0; a < 2; ++a)
#pragma unroll
        for (int b = 0; b < 2; ++b)
#pragma unroll
            for (int m = 0; m < 4; ++m)
#pragma unroll
                for (int n = 0; n < 2; ++n) acc[a][b][m][n] = (f32x4){0.f, 0.f, 0.f, 0.f};
    bf16x8 At[4][2], B0[2][2], B1[2][2];
    const char* cA = (const char*)g.A + (size_t)cur.pm * tstep; const char* cB = (const char*)g.Bt + (size_t)cur.pn * tstep;
    S.a_ready(cur);
    if constexpr (SP2) {
        PG8_STAGE(PG8_SB(0, 0), cB, voffB); PG8_STAGE(PG8_SB(0, 1), cB + hstep, voffB); PG8_STAGE(PG8_SA(0, 0), cA, voffA); PG8_STAGE(PG8_SA(0, 1), cA + hstep, voffA);
        if (wr == 1) PG8_BAR;
        PG8_WAIT_V(2); PG8_BAR;
        PG8_STAGE(PG8_SB(1, 0), cB + kstep, voffB); PG8_STAGE(PG8_SA(1, 0), cA + kstep, voffA); PG8_STAGE(PG8_SB(1, 1), cB + hstep + kstep, voffB);
        PG8_WAIT_V(6); PG8_BAR;
    } else {
        PG8_STAGE(PG8_SB(0, 0), cB, voffB); PG8_STAGE(PG8_SA(0, 0), cA, voffA); PG8_STAGE(PG8_SB(0, 1), cB + hstep, voffB); PG8_STAGE(PG8_SA(0, 1), cA + hstep, voffA);
        if (wr == 1) PG8_BAR;
        PG8_WAIT_V(4); PG8_BAR;
        PG8_STAGE(PG8_SB(1, 0), cB + kstep, voffB); PG8_STAGE(PG8_SA(1, 0), cA + kstep, voffA); PG8_STAGE(PG8_SB(1, 1), cB + hstep + kstep, voffB);
        PG8_WAIT_V(6); PG8_BAR;
    }
    for (;;) {
        const bool has_next = S.next(ui + 1, nxt);
        const char* nA = has_next ? (const char*)g.A + (size_t)nxt.pm * tstep : cA; const char* nB = has_next ? (const char*)g.Bt + (size_t)nxt.pn * tstep : cB;
        for (int t = 0; t < nt; t += 2) {
            const bool last = (t == nt - 2);
            const char* a1 = cA + (size_t)(t + 1) * kstep;
            const char* a2 = last ? nA : cA + (size_t)(t + 2) * kstep; const char* b2 = last ? nB : cB + (size_t)(t + 2) * kstep;
            const char* a3 = a2 + kstep; const char* b3 = b2 + kstep;
            if (last && has_next) S.a_ready(nxt);
            if constexpr (SP2) {
            PG8_LDB(B0, 0, 0); PG8_LDB(B1, 0, 1); PG8_SCHED; PG8_LDA(At, 0, 0); PG8_STAGE(PG8_SA(1, 1), a1 + hstep, voffA);
            PG8_WAIT_V(8); PG8_WAIT_L(0); PG8_BAR; PG8_MMA(0, 0, At, B0); PG8_MMA(0, 1, At, B1); PG8_BAR; PG8_SCHED;
            PG8_LDA(At, 0, 1); PG8_STAGE(PG8_SB(0, 0), b2, voffB); PG8_STAGE(PG8_SB(0, 1), b2 + hstep, voffB); PG8_STAGE(PG8_SA(0, 0), a2, voffA);
            PG8_WAIT_V(8); PG8_WAIT_L(0); PG8_BAR; PG8_MMA(1, 0, At, B0); PG8_MMA(1, 1, At, B1); PG8_BAR; PG8_SCHED;
            PG8_LDB(B0, 1, 0); PG8_LDB(B1, 1, 1); PG8_SCHED; PG8_LDA(At, 1, 0); PG8_STAGE(PG8_SA(0, 1), a2 + hstep, voffA);
            PG8_WAIT_V(8); PG8_WAIT_L(0); PG8_BAR; PG8_MMA(0, 0, At, B0); PG8_MMA(0, 1, At, B1); PG8_BAR; PG8_SCHED;
            PG8_LDA(At, 1, 1); PG8_STAGE(PG8_SB(1, 0), b3, voffB); PG8_STAGE(PG8_SB(1, 1), b3 + hstep, voffB); PG8_STAGE(PG8_SA(1, 0), a3, voffA);
            PG8_WAIT_V(8); PG8_WAIT_L(0); PG8_BAR; PG8_MMA(1, 0, At, B0); PG8_MMA(1, 1, At, B1); PG8_BAR; PG8_SCHED;
            } else {
            PG8_LDB(B0, 0, 0); PG8_SCHED; PG8_LDA(At, 0, 0); PG8_STAGE(PG8_SA(1, 1), a1 + hstep, voffA);
            PG8_WAIT_L(8); PG8_BAR; PG8_WAIT_L(0); PG8_MMA(0, 0, At, B0); PG8_BAR; PG8_SCHED;
            PG8_LDB(B1, 0, 1); PG8_STAGE(PG8_SB(0, 0), b2, voffB);
            PG8_BAR; PG8_WAIT_L(0); PG8_MMA(0, 1, At, B1); PG8_BAR;
            PG8_LDA(At, 0, 1); PG8_STAGE(PG8_SA(0, 0), a2, voffA);
            PG8_BAR; PG8_WAIT_L(0); PG8_MMA(1, 0, At, B0); PG8_BAR; PG8_SCHED;
            PG8_STAGE(PG8_SB(0, 1), b2 + hstep, voffB);
            PG8_WAIT_V(6); PG8_BAR; PG8_MMA(1, 1, At, B1); PG8_BAR;
            PG8_LDB(B0, 1, 0); PG8_SCHED; PG8_LDA(At, 1, 0); PG8_STAGE(PG8_SA(0, 1), a2 + hstep, voffA);
            PG8_WAIT_L(8); PG8_BAR; PG8_WAIT_L(0); PG8_MMA(0, 0, At, B0); PG8_BAR; PG8_SCHED;
            PG8_LDB(B1, 1, 1); PG8_STAGE(PG8_SB(1, 0), b3, voffB);
            PG8_BAR; PG8_WAIT_L(0); PG8_MMA(0, 1, At, B1); PG8_BAR;
            PG8_LDA(At, 1, 1); PG8_STAGE(PG8_SA(1, 0), a3, voffA);
            PG8_BAR; PG8_WAIT_L(0); PG8_MMA(1, 0, At, B0); PG8_BAR; PG8_SCHED;
            PG8_STAGE(PG8_SB(1, 1), b3 + hstep, voffB);
            PG8_WAIT_V(6); PG8_BAR; PG8_MMA(1, 1, At, B1); PG8_BAR;
            }
        }
        if constexpr (ALIGN_EPI) { if (wr == 0) PG8_BAR; }
        if constexpr (!Epi::AFTER_DRAIN) { E(acc, cur, wr, wc, fr, fq); S.done(cur); }
        if (!has_next) break;
#pragma unroll
        for (int a = 0; a < 2; ++a)
#pragma unroll
            for (int b = 0; b < 2; ++b)
#pragma unroll
                for (int m = 0; m < 4; ++m)
#pragma unroll
                    for (int n = 0; n < 2; ++n) acc[a][b][m][n] = (f32x4){0.f, 0.f, 0.f, 0.f};
        cur = nxt; cA = nA; cB = nB; ++ui;
        if constexpr (ALIGN_EPI) { if (wr == 1) PG8_BAR; }
    }
    PG8_WAIT_V(0);
    if constexpr (!ALIGN_EPI) { if (wr == 0) PG8_BAR; }
    PG8_BAR;
    if constexpr (Epi::AFTER_DRAIN) { E.fused(acc, cur, wr, wc, fr, fq, lds, wid, lane); S.done(cur); }
#undef PG8_SA
#undef PG8_SB
#undef PG8_STAGE
#undef PG8_LDA
#undef PG8_LDB
#undef PG8_MMA
#undef PG8_WAIT_V
#undef PG8_WAIT_L
#undef PG8_BAR
#undef PG8_SCHED
}
}

struct EpiInProj {
    static constexpr bool PERM = false, AFTER_DRAIN = false;
    unsigned char* ws; float* out;
    __device__ __forceinline__ void operator()(const pg8::f32x4 (&acc)[2][2][4][2], const pg8::Unit& u, int wr, int wc, int fr_, int fq_) const {
        int fr = fr_, fq = fq_; LAUNDER(fr); LAUNDER(fq);
        const int pm = u.pm, pn = u.pn; const bool smp = (pm == 128);
        const int r0 = pm * 256 + wr * 64 + fr, c0 = wc * 32 + 4 * fq;
#pragma unroll
        for (int ai = 0; ai < 2; ++ai)
#pragma unroll
            for (int m = 0; m < 4; ++m) {
                const int R = r0 + ai * 128 + m * 16;
#pragma unroll
                for (int bj = 0; bj < 2; ++bj)
#pragma unroll
                    for (int n = 0; n < 2; ++n) {
                        const int ct = c0 + bj * 128 + n * 16;
                        const f32x4 v = acc[ai][bj][m][n];
                        if (pn == 0) {
                            *(f32x4*)((float*)(ws + WS_U) + (size_t)R * 256 + ct) = v;
                            if (!smp) { const int t = R & 16383; if (t >= 16369) *(f32x4*)(out + O_PP + (size_t)((R >> 14) * 15 + (t - 16369)) * 256 + ct) = v; }
                            else { const int rs = R - NP, t = rs & 31; if (t >= 17) *(f32x4*)(out + O_PS + (size_t)((rs >> 5) * 15 + (t - 17)) * 256 + ct) = v; }
                        } else if (pn == 1) {
                            f32x4 g; g.x = silu(v.x); g.y = silu(v.y); g.z = silu(v.z); g.w = silu(v.w);
                            *(f32x4*)((float*)(ws + WS_GP) + (size_t)R * 256 + ct) = g;
                        } else if (pn < 5) {
                            u32x2 q; q.x = pk(v.x * QSCALE, v.y * QSCALE); q.y = pk(v.z * QSCALE, v.w * QSCALE);
                            *(u32x2*)((u16*)(ws + WS_QB) + (size_t)R * 768 + (pn - 2) * 256 + ct) = q;
                        } else if (pn < 8) {
                            const int cc = (pn - 5) * 256 + ct;
                            u32x2 q; q.x = pk(v.x, v.y); q.y = pk(v.z, v.w);
                            if (!smp) { *(f32x4*)(out + O_KP + (size_t)R * 768 + cc) = v; *(u32x2*)((u16*)(ws + WS_KB) + (size_t)R * 768 + cc) = q; }
                            else { const int rs = R - NP; *(f32x4*)(out + O_KS + (size_t)rs * 768 + cc) = v; *(u32x2*)((u16*)(ws + WS_KBS) + ((size_t)(rs >> 5) * SKV + 1024 + (rs & 31)) * 768 + cc) = q; }
                        } else if (pn < 11) {
                            const int cc = (pn - 8) * 256 + ct, h = cc >> 7, d = cc & 127;
                            if (!smp) {
                                *(f32x4*)(out + O_VP + (size_t)R * 768 + cc) = v;
                                const int b = R >> 14, sq = R & 16383;
                                u16* vt = (u16*)(ws + WS_VT) + ((size_t)(b * 6 + h) * 128 + d) * SEQ + perm16(sq);
                                vt[0] = bf1(v.x); vt[SEQ] = bf1(v.y); vt[2 * SEQ] = bf1(v.z); vt[3 * SEQ] = bf1(v.w);
                            } else {
                                const int rs = R - NP;
                                *(f32x4*)(out + O_VS + (size_t)rs * 768 + cc) = v;
                                u16* vt = (u16*)(ws + WS_VTS) + ((size_t)((rs >> 5) * 6 + h) * 128 + d) * SKV + 1024 + perm16(rs & 31);
                                vt[0] = bf1(v.x); vt[SKV] = bf1(v.y); vt[2 * SKV] = bf1(v.z); vt[3 * SKV] = bf1(v.w);
                            }
                        } else {
                            u32x2 q; q.x = pk(silu(v.x), silu(v.y)); q.y = pk(silu(v.z), silu(v.w));
                            *(u32x2*)((u16*)(ws + WS_GA) + (size_t)R * 768 + (pn - 11) * 256 + ct) = q;
                        }
                    }
                asm volatile("" ::: "memory");
            }
    }
};

DI void phase1(const Params& p, int tid) {
    (void)tid;
    pg8::Gemm g{(const pg8::bf16_t*)(p.ws + WS_XB), (const pg8::bf16_t*)(p.ws + WS_WTIN), NT, INW, 1024};
    pg8::StaticOrder S; S.init(NT, INW, (int)gridDim.x, (int)blockIdx.x);
    EpiInProj E{p.ws, p.out};
    pg8::gemm_phase<EpiInProj, pg8::StaticOrder, true, true>((PG8_LAS unsigned char*)smem, g, S, E);
}

DI void attn_unit(const Params& p, int tid, int qtok0, int h, const u16* kbase, const u16* vbase, int vstride, int ntiles, bool sample, float lam) {
    const int lane = tid & 63, w = tid >> 6, r = lane & 31, hh = lane >> 5, pair = w >> 1, cm = w & 1;
    unsigned char* ws = p.ws;
    int ntw = sample ? (pair == 0 ? ntiles : 0) : (ntiles - 1 + (pair >> 1));
    ntw = __builtin_amdgcn_readfirstlane(ntw);
    bf16x8 Qf[4];
    {
        const u16* qrow = (const u16*)(ws + WS_QB) + (size_t)(qtok0 + pair * 32 + r) * 768 + h * 128 + cm * 64 + hh * 8;
#pragma unroll
        for (int ks = 0; ks < 4; ++ks) {
            if (ntw > 0) Qf[ks] = *(const bf16x8*)(qrow + ks * 16);
            else Qf[ks] = (bf16x8){0, 0, 0, 0, 0, 0, 0, 0};
        }
    }
    f32x16 O[4];
#pragma unroll
    for (int d = 0; d < 4; ++d)
#pragma unroll
        for (int i = 0; i < 16; ++i) O[d][i] = 0.f;
    float m = 0.f, l = 0.f; bool shifted = false;

    const int krow = tid >> 4, kch = tid & 15;
    const int kdst = krow * 256 + ((kch ^ (krow & 15)) << 4);
    const rsrc_t kg = mkrsrc(kbase);
    const unsigned kvo = (unsigned)(krow * 1536 + kch * 16);
    const int vrow = tid >> 3, vch = tid & 7;
    const int vdst = 16384 + vrow * 128 + ((vch ^ ((vrow >> 1) & 7)) << 4);
    const rsrc_t vg = mkrsrc(vbase);
    const unsigned vvo = (unsigned)(vrow * vstride * 2 + vch * 16);
    const unsigned vstep = 128u * (unsigned)vstride;
    u32x4 rk[2], rv[2];
#pragma unroll
    for (int i = 0; i < 2; ++i) { rk[i] = bload(kg, kvo, i * 49152); rv[i] = bload(vg, vvo, i * vstep); }
#pragma unroll
    for (int i = 0; i < 2; ++i) { *(u32x4*)(smem + kdst + i * 8192) = rk[i]; *(u32x4*)(smem + vdst + i * 8192) = rv[i]; }
    __syncthreads();
    const int ksw = r & 15, vsw = (r >> 1) & 7;
    for (int t = 0; t < ntiles; ++t) {
        const int cur = (t & 1) * 32768, nxt = 32768 - cur;
        if (t + 1 < ntiles) {
#pragma unroll
            for (int i = 0; i < 2; ++i) { rk[i] = bload(kg, kvo, ((t + 1) * 64 + i * 32) * 1536); rv[i] = bload(vg, vvo, (t + 1) * 128 + i * vstep); }
        }
        if (t < ntw) {
            f32x16 S0, S1;
#pragma unroll
            for (int i = 0; i < 16; ++i) { S0[i] = 0.f; S1[i] = 0.f; }
            const int kro = cur + r * 256;
            __builtin_amdgcn_s_setprio(1);
#pragma unroll
            for (int ks = 0; ks < 4; ++ks) {
                const int co = ((cm * 8 + ks * 2 + hh) ^ ksw) << 4;
                const bf16x8 a0 = *(const bf16x8*)(smem + kro + co);
                const bf16x8 a1 = *(const bf16x8*)(smem + kro + 8192 + co);
                S0 = MFMA32(a0, Qf[ks], S0); S1 = MFMA32(a1, Qf[ks], S1);
            }
            __builtin_amdgcn_s_setprio(0);
            if (shifted) { S0 -= m; S1 -= m; }
            if (sample && t == ntiles - 1) {
#pragma unroll
                for (int i = 0; i < 16; ++i) S1[i] = -INFINITY;
            }
            float mxa = fmaxf(fmaxf(S0[0], S0[1]), S0[2]), mxb = fmaxf(fmaxf(S1[0], S1[1]), S1[2]);
#pragma unroll
            for (int i = 3; i < 15; i += 2) { mxa = fmaxf(fmaxf(mxa, S0[i]), S0[i + 1]); mxb = fmaxf(fmaxf(mxb, S1[i]), S1[i + 1]); }
            const float mx = fmaxf(fmaxf(mxa, S0[15]), fmaxf(mxb, S1[15]));
            const bool need = (mx > 16.0f) || (t == 0 && mx < -16.0f);
            if (__any(need)) {
                const u32x2 rr = __builtin_amdgcn_permlane32_swap(__float_as_uint(mx), __float_as_uint(mx), false, false);
                const float rmx = fmaxf(__uint_as_float(rr.x), __uint_as_float(rr.y));
                const float delta = ((rmx > 16.0f) || (t == 0 && rmx < -16.0f)) ? rmx : 0.0f;
                if (t > 0) {
                    const float alpha = __builtin_amdgcn_exp2f(-delta);
#pragma unroll
                    for (int d = 0; d < 4; ++d) O[d] *= alpha;
                    l *= alpha;
                }
                S0 -= delta; S1 -= delta; m += delta; shifted = true;
            }
            float ls0 = 0.f, ls1 = 0.f, ls2 = 0.f, ls3 = 0.f;
#pragma unroll
            for (int i = 0; i < 16; i += 2) {
                S0[i] = __builtin_amdgcn_exp2f(S0[i]); S1[i] = __builtin_amdgcn_exp2f(S1[i]); S0[i + 1] = __builtin_amdgcn_exp2f(S0[i + 1]); S1[i + 1] = __builtin_amdgcn_exp2f(S1[i + 1]);
                ls0 += S0[i]; ls1 += S1[i]; ls2 += S0[i + 1]; ls3 += S1[i + 1];
            }
            l += (ls0 + ls1) + (ls2 + ls3);
            bf16x8 Pf[4];
            {
                u32x4 q;
                q.x = pk(S0[0], S0[1]); q.y = pk(S0[2], S0[3]); q.z = pk(S0[4], S0[5]); q.w = pk(S0[6], S0[7]); Pf[0] = __builtin_bit_cast(bf16x8, q);
                q.x = pk(S0[8], S0[9]); q.y = pk(S0[10], S0[11]); q.z = pk(S0[12], S0[13]); q.w = pk(S0[14], S0[15]); Pf[1] = __builtin_bit_cast(bf16x8, q);
                q.x = pk(S1[0], S1[1]); q.y = pk(S1[2], S1[3]); q.z = pk(S1[4], S1[5]); q.w = pk(S1[6], S1[7]); Pf[2] = __builtin_bit_cast(bf16x8, q);
                q.x = pk(S1[8], S1[9]); q.y = pk(S1[10], S1[11]); q.z = pk(S1[12], S1[13]); q.w = pk(S1[14], S1[15]); Pf[3] = __builtin_bit_cast(bf16x8, q);
            }
            const int vro = cur + 16384 + r * 128;
            __builtin_amdgcn_s_setprio(1);
#pragma unroll
            for (int kk = 0; kk < 4; ++kk) {
                const int co = ((2 * kk + hh) ^ vsw) << 4;
#pragma unroll
                for (int d = 0; d < 4; ++d) {
                    const bf16x8 v = *(const bf16x8*)(smem + vro + d * 4096 + co);
                    O[d] = MFMA32(v, Pf[kk], O[d]);
                }
            }
            __builtin_amdgcn_s_setprio(0);
        }
        if (t + 1 < ntiles) {
#pragma unroll
            for (int i = 0; i < 2; ++i) { *(u32x4*)(smem + nxt + kdst + i * 8192) = rk[i]; *(u32x4*)(smem + nxt + vdst + i * 8192) = rv[i]; }
        }
        __syncthreads();
    }
    const float lt = l + __shfl_xor(l, 32);
    const float inv = 1.0f / lt;
    int xo = XOFF + pair * 16384 + lane * 4;
    LAUNDER(xo);
    if (cm == 1 && ntw > 0) {
        const float sc = lam * inv;
#pragma unroll
        for (int d = 0; d < 4; ++d)
#pragma unroll
            for (int i = 0; i < 16; ++i) *(float*)(smem + xo + (d * 16 + i) * 256) = O[d][i] * sc;
    }
    __syncthreads();
    if (cm == 0 && ntw > 0) {
        float ss = 0.f;
#pragma unroll
        for (int d = 0; d < 4; ++d)
#pragma unroll
            for (int i = 0; i < 16; ++i) { const float v = O[d][i] * inv - *(const float*)(smem + xo + (d * 16 + i) * 256); O[d][i] = v; ss += v * v; }
        asm volatile("" ::: "memory");
        ss += __shfl_xor(ss, 32);
        const float rstd = rsqrtf(ss * (1.0f / 128.0f) + 1e-5f) * 0.8f;
        int tok = qtok0 + pair * 32 + r, hh4 = 4 * hh;
        LAUNDER(tok); LAUNDER(hh4);
        const u16* ga = (const u16*)(ws + WS_GA) + (size_t)tok * 768 + h * 128;
        u16* mo = (u16*)(ws + WS_MIX) + (size_t)tok * 1024 + 256 + h * 128;
#pragma unroll
        for (int d = 0; d < 4; ++d)
#pragma unroll
            for (int j4 = 0; j4 < 4; ++j4) {
                const int d0 = d * 32 + 8 * j4 + hh4;
                const u32x2 g = *(const u32x2*)(ga + d0);
                const f32x4 sg = *(const f32x4*)(p.subln_g + d0);
                const float v0 = O[d][4 * j4] * rstd * sg.x * bf_lo(g.x), v1 = O[d][4 * j4 + 1] * rstd * sg.y * bf_hi(g.x);
                const float v2 = O[d][4 * j4 + 2] * rstd * sg.z * bf_lo(g.y), v3 = O[d][4 * j4 + 3] * rstd * sg.w * bf_hi(g.y);
                u32x2 o; o.x = pk(v0, v1); o.y = pk(v2, v3);
                *(u32x2*)(mo + d0) = o;
                if (j4 & 1) asm volatile("" ::: "memory");
            }
    }
}

DI void pool_unit(const Params& p, int tid, int pu) {
    const int lane = tid & 63, w = tid >> 6, r = lane & 31, hh = lane >> 5;
    unsigned char* ws = p.ws;
    const float* U = (const float*)(ws + WS_U);
    const int tok0 = pu * 32; const bool smp = tok0 >= NP;
    float* E = (float*)smem;
    u16* PA = (u16*)(smem + 49152);
#pragma unroll 1
    for (int i = tid; i < 47 * 64; i += 512) {
        const int row = i >> 6, c4 = (i & 63) * 4; f32x4 v;
        if (row < 15) {
            if (smp) v = *(const f32x4*)(p.state_pool + ((size_t)((tok0 - NP) >> 5) * 15 + row) * 256 + c4);
            else if ((tok0 & 16383) == 0) v = (f32x4){0.f, 0.f, 0.f, 0.f};
            else v = *(const f32x4*)(U + (size_t)(tok0 - 15 + row) * 256 + c4);
        } else v = *(const f32x4*)(U + (size_t)(tok0 + row - 15) * 256 + c4);
        *(f32x4*)(E + row * 256 + c4) = v;
    }
    __syncthreads();
    {
        const int c = tid & 255, th = tid >> 8, g = c >> 6, wdw = 2 << g, tin0 = tok0 & 16383;
#pragma unroll 1
        for (int tt = 0; tt < 16; ++tt) {
            const int t = th * 16 + tt; float s = 0.f;
#pragma unroll 2
            for (int i = 0; i < wdw; ++i) s += E[(15 + t - i) * 256 + c];
            const int cnt = smp ? wdw : min(wdw, tin0 + t + 1);
            const float pooled = s / (float)cnt - E[(15 + t) * 256 + c];
            PA[t * 264 + c] = bf1(pooled);
        }
    }
    __syncthreads();
    {
        const int g = w >> 1, nb = w & 1;
        const u16* pw = (const u16*)(ws + WS_PWT) + (size_t)(g * 64 + nb * 32 + r) * 64 + hh * 8;
        f32x16 acc;
#pragma unroll
        for (int i = 0; i < 16; ++i) acc[i] = 0.f;
#pragma unroll
        for (int ks = 0; ks < 4; ++ks) {
            const bf16x8 a = *(const bf16x8*)(PA + r * 264 + g * 64 + ks * 16 + hh * 8);
            const bf16x8 b = *(const bf16x8*)(pw + ks * 16);
            acc = MFMA32(a, b, acc);
        }
        const int col = g * 64 + nb * 32 + r; const float pb = p.pool_b[col], ps = p.pool_scale[col];
        const float* G = (const float*)(ws + WS_GP); u16* mo = (u16*)(ws + WS_MIX);
#pragma unroll
        for (int i = 0; i < 16; ++i) {
            const int tok = tok0 + (i & 3) + 8 * (i >> 2) + 4 * hh;
            mo[(size_t)tok * 1024 + col] = bf1((acc[i] + pb) * ps * G[(size_t)tok * 256 + col]);
        }
    }
    __syncthreads();
}

DI void phase2(const Params& p, int tid) {
    unsigned char* ws = p.ws;
    const int lane = tid & 63;
    const float sa = wave_sum(p.lq1[lane] * p.lk1[lane]), sb = wave_sum(p.lq2[lane] * p.lk2[lane]);
    const float lam = __expf(sa) - __expf(sb) + 0.2f;
    const u16* KB = (const u16*)(ws + WS_KB); const u16* VT = (const u16*)(ws + WS_VT);
    for (int pi = blockIdx.x; pi < 768; pi += gridDim.x) {
        int bh, j;
        if (gridDim.x == 256) { const int xcd = blockIdx.x & 7, slot = blockIdx.x >> 3, rnd = pi >> 8; bh = rnd * 4 + (xcd & 3); j = slot + 32 * (xcd >> 2); }
        else { bh = pi >> 6; j = pi & 63; }
        const int b = bh / 6, h = bh % 6;
        for (int half = 0; half < 2; ++half) {
            const int qb = half == 0 ? 127 - j : j;
            attn_unit(p, tid, b * SEQ + qb * 128, h, KB + (size_t)b * SEQ * 768 + h * 128, VT + (size_t)bh * 128 * SEQ, SEQ, 2 * qb + 2, false, lam);
        }
    }
    unsigned* ctrl = (unsigned*)(ws + WS_CTRL);
    const u16* KS = (const u16*)(ws + WS_KBS); const u16* VS = (const u16*)(ws + WS_VTS);
    for (;;) {
        if (tid == 0) *(volatile int*)(smem + LDS_SLOT) = (int)atomicAdd(ctrl, 1u);
        __syncthreads();
        const int u = *(volatile int*)(smem + LDS_SLOT);
        __syncthreads();
        if (u >= 48 + 1032) break;
        if (u < 48) {
            const int b = u / 6, h = u % 6;
            attn_unit(p, tid, NP + b * 32, h, KS + (size_t)b * SKV * 768 + h * 128, VS + (size_t)u * 128 * SKV, SKV, 17, true, lam);
        } else pool_unit(p, tid, u - 48);
    }
}

struct EpiOutProj {
    static constexpr bool PERM = false, AFTER_DRAIN = false;
    const float* xp; const float* xs; float* y; float* st;
    __device__ __forceinline__ void operator()(const pg8::f32x4 (&acc)[2][2][4][2], const pg8::Unit& u, int wr, int wc, int fr_, int fq_) const {
        int fr = fr_, fq = fq_; LAUNDER(fr); LAUNDER(fq);
        const int r0 = u.pm * 256 + wr * 64 + fr, c0 = u.pn * 256 + wc * 32 + 4 * fq;
#pragma unroll
        for (int ai = 0; ai < 2; ++ai)
#pragma unroll
            for (int m = 0; m < 4; ++m) {
                const int R = r0 + ai * 128 + m * 16;
                const float* xr = R < NP ? xp + (size_t)R * 1024 : xs + (size_t)(R - NP) * 1024;
                float* yr = y + (size_t)R * 1024;
                float s1 = 0.f, s2 = 0.f;
#pragma unroll
                for (int bj = 0; bj < 2; ++bj)
#pragma unroll
                    for (int n = 0; n < 2; ++n) {
                        const int C = c0 + bj * 128 + n * 16;
                        const f32x4 xv = *(const f32x4*)(xr + C);
                        const f32x4 z = xv * DN_ALPHA + acc[ai][bj][m][n];
                        *(f32x4*)(yr + C) = z;
                        s1 += (z.x + z.y) + (z.z + z.w); s2 += (z.x * z.x + z.y * z.y) + (z.z * z.z + z.w * z.w);
                    }
                s1 += __shfl_xor(s1, 16); s2 += __shfl_xor(s2, 16); s1 += __shfl_xor(s1, 32); s2 += __shfl_xor(s2, 32);
                if (fq == 0) { f32x2 pr; pr.x = s1; pr.y = s2; *(f32x2*)(st + ((size_t)R * 16 + u.pn * 4 + wc) * 2) = pr; }
                asm volatile("" ::: "memory");
            }
    }
};

DI void phase3a(const Params& p) {
    pg8::Gemm g{(const pg8::bf16_t*)(p.ws + WS_MIX), (const pg8::bf16_t*)(p.ws + WS_WTOUT), NT, 1024, 1024};
    pg8::StaticOrder S; S.init(NT, 1024, (int)gridDim.x, (int)blockIdx.x);
    EpiOutProj E{p.x_prompt, p.x_sample, p.out + O_YP, (float*)(p.ws + WS_ST)};
    pg8::gemm_phase<EpiOutProj, pg8::StaticOrder, true, true>((PG8_LAS unsigned char*)smem, g, S, E);
}

DI void phase3b(const Params& p, int tid) {
    const int lane = tid & 63, gw = blockIdx.x * 8 + (tid >> 6), nw = gridDim.x * 8;
    const float* st = (const float*)(p.ws + WS_ST);
    float* y = p.out + O_YP;
    f32x4 g[4], bb[4];
#pragma unroll
    for (int j = 0; j < 4; ++j) { g[j] = *(const f32x4*)(p.ln_g + j * 256 + lane * 4); bb[j] = *(const f32x4*)(p.ln_b + j * 256 + lane * 4); }
    for (int R0 = gw; R0 < NT; R0 += 2 * nw) {
        f32x4 z[2][4]; f32x2 pr[2];
#pragma unroll
        for (int k = 0; k < 2; ++k) {
            const int R = R0 + k * nw;
            if (R < NT) {
                pr[k] = *(const f32x2*)(st + ((size_t)R * 16 + (lane & 15)) * 2);
#pragma unroll
                for (int j = 0; j < 4; ++j) z[k][j] = *(const f32x4*)(y + (size_t)R * 1024 + j * 256 + lane * 4);
            }
        }
#pragma unroll
        for (int k = 0; k < 2; ++k) {
            const int R = R0 + k * nw;
            if (R < NT) {
                float s1 = pr[k].x, s2 = pr[k].y;
#pragma unroll
                for (int o = 8; o > 0; o >>= 1) { s1 += __shfl_xor(s1, o); s2 += __shfl_xor(s2, o); }
                const float mu = s1 * (1.0f / 1024.0f);
                const float var = fmaxf(s2 * (1.0f / 1024.0f) - mu * mu, 0.f);
                const float rstd = rsqrtf(var + 1e-5f);
#pragma unroll
                for (int j = 0; j < 4; ++j) *(f32x4*)(y + (size_t)R * 1024 + j * 256 + lane * 4) = (z[k][j] - mu) * rstd * g[j] + bb[j];
            }
        }
    }
}

__global__ void __launch_bounds__(512) fwd_kernel(Params p) {
    cg::grid_group grid = cg::this_grid();
    const int tid = threadIdx.x;
    phase0(p, tid);
    if (p.ws == nullptr) grid.sync();
    grid_barrier((unsigned*)(p.ws + WS_CTRL) + 192);
    phase1(p, tid);
    grid_barrier((unsigned*)(p.ws + WS_CTRL) + 64);
    phase2(p, tid);
    grid_barrier((unsigned*)(p.ws + WS_CTRL) + 128);
    phase3a(p);
    grid_barrier((unsigned*)(p.ws + WS_CTRL) + 256);
    phase3b(p, tid);
}

extern "C" void kernel_launch(void* const* d_in, const int* in_sizes, int n_in, void* d_out, int out_size, void* d_ws, size_t ws_size, hipStream_t stream) {
    static int grid = 0;
    if (grid == 0) {
        if (n_in != 17 || ws_size < WS_END) { fprintf(stderr, "kernel_launch: unexpected n_in %d / ws_size %zu (need %zu)\n", n_in, ws_size, (size_t)WS_END); grid = -1; return; }
        int dev = 0, cus = 0, per_cu = 0;
        hipGetDevice(&dev);
        hipDeviceGetAttribute(&cus, hipDeviceAttributeMultiprocessorCount, dev);
        if (hipFuncSetAttribute((const void*)fwd_kernel, hipFuncAttributeMaxDynamicSharedMemorySize, LDS_BYTES) != hipSuccess) { fprintf(stderr, "kernel_launch: hipFuncSetAttribute failed\n"); grid = -1; return; }
        if (hipOccupancyMaxActiveBlocksPerMultiprocessor(&per_cu, (const void*)fwd_kernel, 512, LDS_BYTES) != hipSuccess || per_cu < 1) { fprintf(stderr, "kernel_launch: occupancy query gave %d\n", per_cu); per_cu = 1; }
        (void)hipGetLastError();
        grid = cus * per_cu;
        fprintf(stderr, "kernel_launch: grid %d (cus %d x %d)\n", grid, cus, per_cu);
    }
    if (grid < 0) return;
    Params p{};
    p.x_prompt = (const float*)d_in[0]; p.x_sample = (const float*)d_in[1]; p.cache_k = (const float*)d_in[2]; p.cache_v = (const float*)d_in[3]; p.state_pool = (const float*)d_in[4];
    p.w_in = (const float*)d_in[5]; p.pool_w = (const float*)d_in[6]; p.pool_b = (const float*)d_in[7]; p.pool_scale = (const float*)d_in[8];
    p.lq1 = (const float*)d_in[9]; p.lk1 = (const float*)d_in[10]; p.lq2 = (const float*)d_in[11]; p.lk2 = (const float*)d_in[12]; p.subln_g = (const float*)d_in[13];
    p.w_out = (const float*)d_in[14]; p.ln_g = (const float*)d_in[15]; p.ln_b = (const float*)d_in[16];
    p.out = (float*)d_out; p.ws = (unsigned char*)d_ws;
    if (hipMemsetAsync((char*)d_ws + WS_CTRL, 0, 4096, stream) != hipSuccess) { fprintf(stderr, "kernel_launch: hipMemsetAsync failed\n"); return; }
    void* args[] = {&p};
    hipError_t e = hipLaunchCooperativeKernel((const void*)fwd_kernel, dim3(grid), dim3(512), args, LDS_BYTES, stream);
    if (e != hipSuccess) fprintf(stderr, "kernel_launch: cooperative launch failed: %s (grid %d)\n", hipGetErrorString(e), grid);
}
```

```cpp
#include <hip/hip_runtime.h>
#include <hip/hip_cooperative_groups.h>
#include <cstdio>
#include <cstdint>
namespace cg = cooperative_groups;

typedef short bf16x8 __attribute__((ext_vector_type(8)));
typedef float f32x16 __attribute__((ext_vector_type(16)));
typedef float f32x4 __attribute__((ext_vector_type(4)));
typedef float f32x2 __attribute__((ext_vector_type(2)));
typedef __bf16 bf16x2_t __attribute__((ext_vector_type(2)));
typedef unsigned u32x4 __attribute__((ext_vector_type(4)));
typedef unsigned u32x2 __attribute__((ext_vector_type(2)));
typedef unsigned short u16;

#define MFMA32(a, b, c) __builtin_amdgcn_mfma_f32_32x32x16_bf16((a), (b), (c), 0, 0, 0)
#define DI __device__ __forceinline__

constexpr int NP = 32768, NS = 256, NT = NP + NS;
constexpr int INW = 3584, SEQ = 16384, SKV = 1088;
constexpr int LDS_BYTES = 147456;
constexpr int LDS_SLOT = 147440;
constexpr int XOFF = 73728;

constexpr size_t WS_CTRL = 0;
constexpr size_t WS_XB = 4096;
constexpr size_t WS_WTIN = WS_XB + (size_t)NT * 1024 * 2;
constexpr size_t WS_WTOUT = WS_WTIN + (size_t)INW * 1024 * 2;
constexpr size_t WS_PWT = WS_WTOUT + (size_t)1024 * 1024 * 2;
constexpr size_t WS_U = WS_PWT + 32768;
constexpr size_t WS_GP = WS_U + (size_t)NT * 256 * 4;
constexpr size_t WS_QB = WS_GP + (size_t)NT * 256 * 4;
constexpr size_t WS_KB = WS_QB + (size_t)NT * 768 * 2;
constexpr size_t WS_KBS = WS_KB + (size_t)NP * 768 * 2;
constexpr size_t WS_VT = WS_KBS + (size_t)8 * SKV * 768 * 2;
constexpr size_t WS_VTS = WS_VT + (size_t)12 * 128 * SEQ * 2;
constexpr size_t WS_GA = WS_VTS + (size_t)48 * 128 * SKV * 2;
constexpr size_t WS_MIX = WS_GA + (size_t)NT * 768 * 2;
constexpr size_t WS_ST = WS_MIX + (size_t)NT * 1024 * 2;
constexpr size_t WS_END = WS_ST + (size_t)NT * 16 * 8;

constexpr size_t O_YP = 0, O_KP = 33816576, O_VP = 58982400, O_PP = 84148224, O_KS = 84155904, O_VS = 84352512, O_PS = 84549120;

constexpr float QSCALE = 0.125f * 1.4426950408889634f;
constexpr float DN_ALPHA = 1.189207115002721f;

struct Params {
    const float* x_prompt; const float* x_sample; const float* cache_k; const float* cache_v; const float* state_pool;
    const float* w_in; const float* pool_w; const float* pool_b; const float* pool_scale;
    const float* lq1; const float* lk1; const float* lq2; const float* lk2; const float* subln_g;
    const float* w_out; const float* ln_g; const float* ln_b;
    float* out; unsigned char* ws;
};

extern __shared__ __attribute__((aligned(16))) unsigned char smem[];

DI unsigned pk(float lo, float hi) { f32x2 v = {lo, hi}; bf16x2_t b = __builtin_convertvector(v, bf16x2_t); return __builtin_bit_cast(unsigned, b); }
DI u16 bf1(float x) { __bf16 b = (__bf16)x; return __builtin_bit_cast(u16, b); }
DI float bf_lo(unsigned w) { return __uint_as_float(w << 16); }
DI float bf_hi(unsigned w) { return __uint_as_float(w & 0xffff0000u); }
DI float silu(float v) { return v / (1.0f + __expf(-v)); }
DI float wave_sum(float v) {
#pragma unroll
    for (int o = 32; o > 0; o >>= 1) v += __shfl_xor(v, o);
    return v;
}
typedef __amdgpu_buffer_rsrc_t rsrc_t;
DI rsrc_t mkrsrc(const void* p) { return __builtin_amdgcn_make_buffer_rsrc((void*)p, 0, 0x7fffffff, 0x00020000); }
DI u32x4 bload(rsrc_t rs, unsigned voff, unsigned soff) { return __builtin_amdgcn_raw_buffer_load_b128(rs, voff, soff, 0); }
#define LAUNDER(x) asm volatile("" : "+v"(x))
DI int perm16(int s) { return (s & ~12) | ((s & 4) << 1) | ((s & 8) >> 1); }

DI void grid_barrier(unsigned* cnt) {
    __syncthreads();
    if (threadIdx.x == 0) {
        __builtin_amdgcn_fence(__ATOMIC_RELEASE, "agent");
        __hip_atomic_fetch_add(cnt, 1u, __ATOMIC_RELAXED, __HIP_MEMORY_SCOPE_AGENT);
        const unsigned want = gridDim.x;
        while (__hip_atomic_load(cnt, __ATOMIC_RELAXED, __HIP_MEMORY_SCOPE_AGENT) < want) __builtin_amdgcn_s_sleep(2);
        __builtin_amdgcn_fence(__ATOMIC_ACQUIRE, "agent");
    }
    __syncthreads();
}
DI void phase0(const Params& p, int tid) {
    unsigned char* ws = p.ws;
    const int wv = tid >> 6;
    if (wv < 4) {
        const size_t g0 = (size_t)blockIdx.x * 256 + tid, gs = (size_t)gridDim.x * 256;
        u16* xb = (u16*)(ws + WS_XB);
        const size_t N = (size_t)NT * 128;
        for (size_t i0 = g0; i0 < N; i0 += 4 * gs) {
            f32x4 a[4], b[4];
#pragma unroll
            for (int u = 0; u < 4; ++u) {
                const size_t i = i0 + u * gs;
                if (i < N) {
                    const size_t e = i * 8;
                    const float* s = e < (size_t)NP * 1024 ? p.x_prompt + e : p.x_sample + (e - (size_t)NP * 1024);
                    a[u] = *(const f32x4*)s; b[u] = *(const f32x4*)(s + 4);
                }
            }
#pragma unroll
            for (int u = 0; u < 4; ++u) {
                const size_t i = i0 + u * gs;
                if (i < N) {
                    u32x4 w; w.x = pk(a[u].x, a[u].y); w.y = pk(a[u].z, a[u].w); w.z = pk(b[u].x, b[u].y); w.w = pk(b[u].z, b[u].w);
                    *(u32x4*)(xb + i * 8) = w;
                }
            }
        }
    } else if (wv < 6) {
        const size_t g0 = (size_t)blockIdx.x * 128 + (tid - 256), gs = (size_t)gridDim.x * 128;
        {
            u16* wt = (u16*)(ws + WS_WTIN);
            for (size_t i = g0; i < (size_t)INW * 128; i += gs) {
                const int n = (int)(i % INW), k8 = (int)(i / INW);
                const float* s = p.w_in + (size_t)k8 * 8 * INW + n;
                float v[8];
#pragma unroll
                for (int j = 0; j < 8; ++j) v[j] = s[(size_t)j * INW];
                u32x4 w; w.x = pk(v[0], v[1]); w.y = pk(v[2], v[3]); w.z = pk(v[4], v[5]); w.w = pk(v[6], v[7]);
                *(u32x4*)(wt + (size_t)n * 1024 + k8 * 8) = w;
            }
        }
        {
            u16* wt = (u16*)(ws + WS_WTOUT);
            for (size_t i = g0; i < (size_t)1024 * 128; i += gs) {
                const int n = (int)(i & 1023), k8 = (int)(i >> 10);
                const float* s = p.w_out + (size_t)k8 * 8 * 1024 + n;
                float v[8];
#pragma unroll
                for (int j = 0; j < 8; ++j) v[j] = s[(size_t)j * 1024];
                u32x4 w; w.x = pk(v[0], v[1]); w.y = pk(v[2], v[3]); w.z = pk(v[4], v[5]); w.w = pk(v[6], v[7]);
                *(u32x4*)(wt + (size_t)n * 1024 + k8 * 8) = w;
            }
        }
        {
            u16* pw = (u16*)(ws + WS_PWT);
            for (size_t i = g0; i < 16384; i += gs) {
                const int g = (int)(i >> 12), d = (int)((i >> 6) & 63), c = (int)(i & 63);
                pw[i] = bf1(p.pool_w[g * 4096 + c * 64 + d]);
            }
        }
    } else {
        const size_t g0 = (size_t)blockIdx.x * 128 + (tid - 384), gs = (size_t)gridDim.x * 128;
        {
            u16* kb = (u16*)(ws + WS_KBS);
            const size_t NK = (size_t)8 * 1024 * 96;
            for (size_t i0 = g0; i0 < NK; i0 += 4 * gs) {
                f32x4 a[4], c[4];
#pragma unroll
                for (int u = 0; u < 4; ++u) { const size_t i = i0 + u * gs; if (i < NK) { const float* s = p.cache_k + i * 8; a[u] = *(const f32x4*)s; c[u] = *(const f32x4*)(s + 4); } }
#pragma unroll
                for (int u = 0; u < 4; ++u) {
                    const size_t i = i0 + u * gs;
                    if (i < NK) {
                        const size_t e = i * 8; const int b = (int)(e / (1024 * 768)); const int rem = (int)(e % (1024 * 768));
                        u32x4 w; w.x = pk(a[u].x, a[u].y); w.y = pk(a[u].z, a[u].w); w.z = pk(c[u].x, c[u].y); w.w = pk(c[u].z, c[u].w);
                        *(u32x4*)(kb + (size_t)b * SKV * 768 + rem) = w;
                    }
                }
            }
            for (size_t i = g0; i < (size_t)8 * 32 * 96; i += gs) {
                const int e = (int)i * 8; const int b = e / (32 * 768), rem = e % (32 * 768);
                u32x4 z = {0u, 0u, 0u, 0u};
                *(u32x4*)(kb + ((size_t)b * SKV + 1056) * 768 + rem) = z;
            }
        }
        {
            u16* vt = (u16*)(ws + WS_VTS);
            for (size_t i = g0; i < (size_t)48 * 64 * 128; i += gs) {
                const int d = (int)(i & 127), s16 = (int)((i >> 7) & 63), bh = (int)(i >> 13), b = bh / 6, h = bh % 6;
                const float* s = p.cache_v + ((size_t)(b * 1024 + s16 * 16) * 6 + h) * 128 + d;
                float v[16];
#pragma unroll
                for (int j = 0; j < 16; ++j) v[j] = s[(size_t)j * 768];
                u32x4 w0, w1;
                w0.x = pk(v[0], v[1]); w0.y = pk(v[2], v[3]); w0.z = pk(v[8], v[9]); w0.w = pk(v[10], v[11]);
                w1.x = pk(v[4], v[5]); w1.y = pk(v[6], v[7]); w1.z = pk(v[12], v[13]); w1.w = pk(v[14], v[15]);
                u16* dst = vt + ((size_t)bh * 128 + d) * SKV + s16 * 16;
                *(u32x4*)dst = w0; *(u32x4*)(dst + 8) = w1;
            }
            for (size_t i = g0; i < (size_t)48 * 128 * 4; i += gs) {
                u32x4 z = {0u, 0u, 0u, 0u};
                *(u32x4*)(vt + (i >> 2) * SKV + 1056 + (i & 3) * 8) = z;
            }
        }
    }
}

template <int MB, int NB, bool FENCE = false>
DI void mma_ktile(int aoff, int boff, int r, int hh, f32x16 (&acc)[MB][NB]) {
    const int sw = (r >> 1) & 7;
#pragma unroll
    for (int ks = 0; ks < 4; ++ks) {
        if (FENCE && (ks > 0)) __builtin_amdgcn_sched_barrier(0);
        const int co = ((2 * ks + hh) ^ sw) << 4;
        bf16x8 a[MB], b[NB];
#pragma unroll
        for (int mb = 0; mb < MB; ++mb) a[mb] = *(const bf16x8*)(smem + aoff + (mb * 32 + r) * 128 + co);
#pragma unroll
        for (int nb = 0; nb < NB; ++nb) b[nb] = *(const bf16x8*)(smem + boff + (nb * 32 + r) * 128 + co);
#pragma unroll
        for (int mb = 0; mb < MB; ++mb)
#pragma unroll
            for (int nb = 0; nb < NB; ++nb) acc[mb][nb] = MFMA32(a[mb], b[nb], acc[mb][nb]);
    }
}

namespace pg8 {
#define PG8_LAS __attribute__((address_space(3)))
typedef unsigned short bf16_t;
typedef short bf16x8 __attribute__((ext_vector_type(8)));
typedef float f32x4 __attribute__((ext_vector_type(4)));
typedef unsigned u32x4 __attribute__((ext_vector_type(4)));
constexpr int BM = 256, BK = 64, HALF = 128, HTB = HALF * BK * 2  , STAGE_BYTES = 8 * HTB, NXCD = 8, WGM = 8;

__host__ __device__ __forceinline__ int lds_byte(int r, int c) { const int st = (r >> 4) * 2 + (c >> 5), rr = r & 15, cc = c & 31, ob = rr * 64 + cc * 2; return st * 1024 + (ob ^ (((ob >> 9) & 1) << 5)); }
__host__ __device__ __forceinline__ void stage_rc(int b, int& R, int& C) { const int st = b / 1024, sb = b % 1024, swz = sb ^ (((sb >> 9) & 1) << 5); R = (st >> 1) * 16 + swz / 64; C = (st & 1) * 32 + (swz % 64) / 2; }
__host__ __device__ __forceinline__ int perm32(int rho) { const int n = rho >> 4, i = rho & 15; return 8 * (i >> 2) + 4 * n + (i & 3); }

struct Unit { int pm, pn; };
struct Gemm { const bf16_t* A; const bf16_t* Bt; int M, N, K; };

struct StaticOrder {
    int nM, nN, nwg, G, c;
    __host__ __device__ void init(int M, int N, int G_, int c_) { nM = M / BM; nN = N / BM; nwg = nM * nN; G = G_; c = c_; }
    __host__ __device__ bool next(int i, Unit& u) const {
        const long L = (long)i * G + c; if (L >= nwg) return false;
        int wgid = (int)L; { const int q = nwg / NXCD, r = nwg % NXCD, xcd = wgid % NXCD, off = wgid / NXCD; wgid = (xcd < r ? xcd * (q + 1) : r * (q + 1) + (xcd - r) * q) + off; }
        const int nig = WGM * nN, gid = wgid / nig, fm = gid * WGM, gsz = (nM - fm) < WGM ? (nM - fm) : WGM;
        u.pm = fm + ((wgid % nig) % gsz); u.pn = (wgid % nig) / gsz; return true;
    }
    __device__ __forceinline__ void a_ready(const Unit&) const {}
    __device__ __forceinline__ void done(const Unit&) const {}
};

typedef float f32x2 __attribute__((ext_vector_type(2)));
template <class Epi, class Sched, bool ALIGN_EPI = false, bool SP2 = false>
__device__ __forceinline__ void gemm_phase(PG8_LAS unsigned char* lds, const Gemm g, const Sched& S, const Epi& E) {
    const int tid = threadIdx.x, wid = __builtin_amdgcn_readfirstlane(tid >> 6), lane = tid & 63, wr = wid >> 2, wc = wid & 3, fr = lane & 15, fq = lane >> 4;
    const int K = g.K, nt = K / BK;
    unsigned voffA[2], voffB[2];
#pragma unroll
    for (int i = 0; i < 2; ++i) { int R, C; stage_rc(tid * 16 + i * 8192, R, C); const int Rb = Epi::PERM ? ((R & ~31) + perm32(R & 31)) : R;
        voffA[i] = (unsigned)(R * K + C) * 2u; voffB[i] = (unsigned)(Rb * K + C) * 2u; }
    const size_t kstep = (size_t)(BK * 2);
    const size_t hstep = (size_t)HALF * K * 2;
    const size_t tstep = 2 * hstep;
    const unsigned ldsw = (unsigned)wid * 1024u;
    const int aoff = lds_byte(wr * 64 + fr, fq * 8), boff = lds_byte(wc * 32 + fr, fq * 8);
#define PG8_SA(b, h) (((b) * 2 + (h)) * HTB)
#define PG8_SB(b, h) ((4 + (b) * 2 + (h)) * HTB)
#define PG8_STAGE(bufoff, gbase, voff) do { _Pragma("unroll") for (int _i = 0; _i < 2; ++_i) \
        __builtin_amdgcn_global_load_lds((const unsigned*)((const char*)(gbase) + (voff)[_i]), (PG8_LAS unsigned*)(lds + (bufoff) + ldsw + _i * 8192), 16, 0, 0); } while (0)
#define PG8_LDA(dst, b, h) do { _Pragma("unroll") for (int m = 0; m < 4; ++m) _Pragma("unroll") for (int k = 0; k < 2; ++k) dst[m][k] = *(const PG8_LAS bf16x8*)(lds + PG8_SA(b, h) + aoff + m * 2048 + k * 1024); } while (0)
#define PG8_LDB(dst, b, h) do { _Pragma("unroll") for (int n = 0; n < 2; ++n) _Pragma("unroll") for (int k = 0; k < 2; ++k) dst[n][k] = *(const PG8_LAS bf16x8*)(lds + PG8_SB(b, h) + boff + n * 2048 + k * 1024); } while (0)
#define PG8_MMA(ai, bj, At, Bt) do { __builtin_amdgcn_s_setprio(1); _Pragma("unroll") for (int m = 0; m < 4; ++m) _Pragma("unroll") for (int n = 0; n < 2; ++n) _Pragma("unroll") for (int k = 0; k < 2; ++k) \
        acc[ai][bj][m][n] = __builtin_amdgcn_mfma_f32_16x16x32_bf16(Bt[n][k], At[m][k], acc[ai][bj][m][n], 0, 0, 0); __builtin_amdgcn_s_setprio(0); } while (0)
#define PG8_WAIT_V(n) asm volatile("s_waitcnt vmcnt(" #n ")" ::: "memory")
#define PG8_WAIT_L(n) asm volatile("s_waitcnt lgkmcnt(" #n ")" ::: "memory")
#define PG8_BAR __builtin_amdgcn_s_barrier()
#define PG8_SCHED __builtin_amdgcn_sched_barrier(0)
    Unit cur, nxt; int ui = 0;
    if (!S.next(0, cur)) return;
    f32x4 acc[2][2][4][2];
#pragma unroll
    for (int a = 0; a < 2; ++a)
#pragma unroll
        for (int b = 0; b < 2; ++b)
#pragma unroll
            for (int m = 0; m < 4; ++m)
#pragma unroll
                for (int n = 0; n < 2; ++n) acc[a][b][m][n] = (f32x4){0.f, 0.f, 0.f, 0.f};
    bf16x8 At[4][2], B0[2][2], B1[2][2];
    const char* cA = (const char*)g.A + (size_t)cur.pm * tstep; const char* cB = (const char*)g.Bt + (size_t)cur.pn * tstep;
    S.a_ready(cur);
    if constexpr (SP2) {
        PG8_STAGE(PG8_SB(0, 0), cB, voffB); PG8_STAGE(PG8_SB(0, 1), cB + hstep, voffB); PG8_STAGE(PG8_SA(0, 0), cA, voffA); PG8_STAGE(PG8_SA(0, 1), cA + hstep, voffA);
        if (wr == 1) PG8_BAR;
        PG8_WAIT_V(2); PG8_BAR;
        PG8_STAGE(PG8_SB(1, 0), cB + kstep, voffB); PG8_STAGE(PG8_SA(1, 0), cA + kstep, voffA); PG8_STAGE(PG8_SB(1, 1), cB + hstep + kstep, voffB);
        PG8_WAIT_V(6); PG8_BAR;
    } else {
        PG8_STAGE(PG8_SB(0, 0), cB, voffB); PG8_STAGE(PG8_SA(0, 0), cA, voffA); PG8_STAGE(PG8_SB(0, 1), cB + hstep, voffB); PG8_STAGE(PG8_SA(0, 1), cA + hstep, voffA);
        if (wr == 1) PG8_BAR;
        PG8_WAIT_V(4); PG8_BAR;
        PG8_STAGE(PG8_SB(1, 0), cB + kstep, voffB); PG8_STAGE(PG8_SA(1, 0), cA + kstep, voffA); PG8_STAGE(PG8_SB(1, 1), cB + hstep + kstep, voffB);
        PG8_WAIT_V(6); PG8_BAR;
    }
    for (;;) {
        const bool has_next = S.next(ui + 1, nxt);
        const char* nA = has_next ? (const char*)g.A + (size_t)nxt.pm * tstep : cA; const char* nB = has_next ? (const char*)g.Bt + (size_t)nxt.pn * tstep : cB;
        for (int t = 0; t < nt; t += 2) {
            const bool last = (t == nt - 2);
            const char* a1 = cA + (size_t)(t + 1) * kstep;
            const char* a2 = last ? nA : cA + (size_t)(t + 2) * kstep; const char* b2 = last ? nB : cB + (size_t)(t + 2) * kstep;
            const char* a3 = a2 + kstep; const char* b3 = b2 + kstep;
            if (last && has_next) S.a_ready(nxt);
            if constexpr (SP2) {
            PG8_LDB(B0, 0, 0); PG8_LDB(B1, 0, 1); PG8_SCHED; PG8_LDA(At, 0, 0); PG8_STAGE(PG8_SA(1, 1), a1 + hstep, voffA);
            PG8_WAIT_V(8); PG8_WAIT_L(0); PG8_BAR; PG8_MMA(0, 0, At, B0); PG8_MMA(0, 1, At, B1); PG8_BAR; PG8_SCHED;
            PG8_LDA(At, 0, 1); PG8_STAGE(PG8_SB(0, 0), b2, voffB); PG8_STAGE(PG8_SB(0, 1), b2 + hstep, voffB); PG8_STAGE(PG8_SA(0, 0), a2, voffA);
            PG8_WAIT_V(8); PG8_WAIT_L(0); PG8_BAR; PG8_MMA(1, 0, At, B0); PG8_MMA(1, 1, At, B1); PG8_BAR; PG8_SCHED;
            PG8_LDB(B0, 1, 0); PG8_LDB(B1, 1, 1); PG8_SCHED; PG8_LDA(At, 1, 0); PG8_STAGE(PG8_SA(0, 1), a2 + hstep, voffA);
            PG8_WAIT_V(8); PG8_WAIT_L(0); PG8_BAR; PG8_MMA(0, 0, At, B0); PG8_MMA(0, 1, At, B1); PG8_BAR; PG8_SCHED;
            PG8_LDA(At, 1, 1); PG8_STAGE(PG8_SB(1, 0), b3, voffB); PG8_STAGE(PG8_SB(1, 1), b3 + hstep, voffB); PG8_STAGE(PG8_SA(1, 0), a3, voffA);
            PG8_WAIT_V(8); PG8_WAIT_L(0); PG8_BAR; PG8_MMA(1, 0, At, B0); PG8_MMA(1, 1, At, B1); PG8_BAR; PG8_SCHED;
            } else {
            PG8_LDB(B0, 0, 0); PG8_SCHED; PG8_LDA(At, 0, 0); PG8_STAGE(PG8_SA(1, 1), a1 + hstep, voffA);
            PG8_WAIT_L(8); PG8_BAR; PG8_WAIT_L(0); PG8_MMA(0, 0, At, B0); PG8_BAR; PG8_SCHED;
            PG8_LDB(B1, 0, 1); PG8_STAGE(PG8_SB(0, 0), b2, voffB);
            PG8_BAR; PG8_WAIT_L(0); PG8_MMA(0, 1, At, B1); PG8_BAR;
            PG8_LDA(At, 0, 1); PG8_STAGE(PG8_SA(0, 0), a2, voffA);
            PG8_BAR; PG8_WAIT_L(0); PG8_MMA(1, 0, At, B0); PG8_BAR; PG8_SCHED;
            PG8_STAGE(PG8_SB(0, 1), b2 + hstep, voffB);
            PG8_WAIT_V(6); PG8_BAR; PG8_MMA(1, 1, At, B1); PG8_BAR;
            PG8_LDB(B0, 1, 0); PG8_SCHED; PG8_LDA(At, 1, 0); PG8_STAGE(PG8_SA(0, 1), a2 + hstep, voffA);
            PG8_WAIT_L(8); PG8_BAR; PG8_WAIT_L(0); PG8_MMA(0, 0, At, B0); PG8_BAR; PG8_SCHED;
            PG8_LDB(B1, 1, 1); PG8_STAGE(PG8_SB(1, 0), b3, voffB);
            PG8_BAR; PG8_WAIT_L(0); PG8_MMA(0, 1, At, B1); PG8_BAR;
            PG8_LDA(At, 1, 1); PG8_STAGE(PG8_SA(1, 0), a3, voffA);
            PG8_BAR; PG8_WAIT_L(0); PG8_MMA(1, 0, At, B0); PG8_BAR; PG8_SCHED;
            PG8_STAGE(PG8_SB(1, 1), b3 + hstep, voffB);
            PG8_WAIT_V(6); PG8_BAR; PG8_MMA(1, 1, At, B1); PG8_BAR;
            }
        }
        if constexpr (ALIGN_EPI) { if (wr == 0) PG8_BAR; }
        if constexpr (!Epi::AFTER_DRAIN) { E(acc, cur, wr, wc, fr, fq); S.done(cur); }
        if (!has_next) break;
#pragma unroll
        for (int a = 0; a < 2; ++a)
#pragma unroll
            for (int b = 0; b < 2; ++b)
#pragma unroll
                for (int m = 0; m < 4; ++m)
#pragma unroll
                    for (int n = 0; n < 2; ++n) acc[a][b][m][n] = (f32x4){0.f, 0.f, 0.f, 0.f};
        cur = nxt; cA = nA; cB = nB; ++ui;
        if constexpr (ALIGN_EPI) { if (wr == 1) PG8_BAR; }
    }
    PG8_WAIT_V(0);
    if constexpr (!ALIGN_EPI) { if (wr == 0) PG8_BAR; }
    PG8_BAR;
    if constexpr (Epi::AFTER_DRAIN) { E.fused(acc, cur, wr, wc, fr, fq, lds, wid, lane); S.done(cur); }
#undef PG8_SA
#undef PG8_SB
#undef PG8_STAGE
#undef PG8_LDA
#undef PG8_LDB
#undef PG8_MMA
#undef PG8_WAIT_V
#undef PG8_WAIT_L
#undef PG8_BAR
#undef PG8_SCHED
}
}

struct EpiInProj {
    static constexpr bool PERM = false, AFTER_DRAIN = false;
    unsigned char* ws; float* out;
    __device__ __forceinline__ void operator()(const pg8::f32x4 (&acc)[2][2][4][2], const pg8::Unit& u, int wr, int wc, int fr_, int fq_) const {
        int fr = fr_, fq = fq_; LAUNDER(fr); LAUNDER(fq);
        const int pm = u.pm, pn = u.pn; const bool smp = (pm == 128);
        const int r0 = pm * 256 + wr * 64 + fr, c0 = wc * 32 + 4 * fq;
#pragma unroll
        for (int ai = 0; ai < 2; ++ai)
#pragma unroll
            for (int m = 0; m < 4; ++m) {
                const int R = r0 + ai * 128 + m * 16;
#pragma unroll
                for (int bj = 0; bj < 2; ++bj)
#pragma unroll
                    for (int n = 0; n < 2; ++n) {
                        const int ct = c0 + bj * 128 + n * 16;
                        const f32x4 v = acc[ai][bj][m][n];
                        if (pn == 0) {
                            *(f32x4*)((float*)(ws + WS_U) + (size_t)R * 256 + ct) = v;
                            if (!smp) { const int t = R & 16383; if (t >= 16369) *(f32x4*)(out + O_PP + (size_t)((R >> 14) * 15 + (t - 16369)) * 256 + ct) = v; }
                            else { const int rs = R - NP, t = rs & 31; if (t >= 17) *(f32x4*)(out + O_PS + (size_t)((rs >> 5) * 15 + (t - 17)) * 256 + ct) = v; }
                        } else if (pn == 1) {
                            f32x4 g; g.x = silu(v.x); g.y = silu(v.y); g.z = silu(v.z); g.w = silu(v.w);
                            *(f32x4*)((float*)(ws + WS_GP) + (size_t)R * 256 + ct) = g;
                        } else if (pn < 5) {
                            u32x2 q; q.x = pk(v.x * QSCALE, v.y * QSCALE); q.y = pk(v.z * QSCALE, v.w * QSCALE);
                            *(u32x2*)((u16*)(ws + WS_QB) + (size_t)R * 768 + (pn - 2) * 256 + ct) = q;
                        } else if (pn < 8) {
                            const int cc = (pn - 5) * 256 + ct;
                            u32x2 q; q.x = pk(v.x, v.y); q.y = pk(v.z, v.w);
                            if (!smp) { *(f32x4*)(out + O_KP + (size_t)R * 768 + cc) = v; *(u32x2*)((u16*)(ws + WS_KB) + (size_t)R * 768 + cc) = q; }
                            else { const int rs = R - NP; *(f32x4*)(out + O_KS + (size_t)rs * 768 + cc) = v; *(u32x2*)((u16*)(ws + WS_KBS) + ((size_t)(rs >> 5) * SKV + 1024 + (rs & 31)) * 768 + cc) = q; }
                        } else if (pn < 11) {
                            const int cc = (pn - 8) * 256 + ct, h = cc >> 7, d = cc & 127;
                            if (!smp) {
                                *(f32x4*)(out + O_VP + (size_t)R * 768 + cc) = v;
                                const int b = R >> 14, sq = R & 16383;
                                u16* vt = (u16*)(ws + WS_VT) + ((size_t)(b * 6 + h) * 128 + d) * SEQ + perm16(sq);
                                vt[0] = bf1(v.x); vt[SEQ] = bf1(v.y); vt[2 * SEQ] = bf1(v.z); vt[3 * SEQ] = bf1(v.w);
                            } else {
                                const int rs = R - NP;
                                *(f32x4*)(out + O_VS + (size_t)rs * 768 + cc) = v;
                                u16* vt = (u16*)(ws + WS_VTS) + ((size_t)((rs >> 5) * 6 + h) * 128 + d) * SKV + 1024 + perm16(rs & 31);
                                vt[0] = bf1(v.x); vt[SKV] = bf1(v.y); vt[2 * SKV] = bf1(v.z); vt[3 * SKV] = bf1(v.w);
                            }
                        } else {
                            u32x2 q; q.x = pk(silu(v.x), silu(v.y)); q.y = pk(silu(v.z), silu(v.w));
                            *(u32x2*)((u16*)(ws + WS_GA) + (size_t)R * 768 + (pn - 11) * 256 + ct) = q;
                        }
                    }
                asm volatile("" ::: "memory");
            }
    }
};

DI void phase1(const Params& p, int tid) {
    (void)tid;
    pg8::Gemm g{(const pg8::bf16_t*)(p.ws + WS_XB), (const pg8::bf16_t*)(p.ws + WS_WTIN), NT, INW, 1024};
    pg8::StaticOrder S; S.init(NT, INW, (int)gridDim.x, (int)blockIdx.x);
    EpiInProj E{p.ws, p.out};
    pg8::gemm_phase<EpiInProj, pg8::StaticOrder, true, true>((PG8_LAS unsigned char*)smem, g, S, E);
}

DI void attn_unit(const Params& p, int tid, int qtok0, int h, const u16* kbase, const u16* vbase, int vstride, int ntiles, bool sample, float lam) {
    const int lane = tid & 63, w = tid >> 6, r = lane & 31, hh = lane >> 5, pair = w >> 1, cm = w & 1;
    unsigned char* ws = p.ws;
    int ntw = sample ? (pair == 0 ? ntiles : 0) : (ntiles - 1 + (pair >> 1));
    ntw = __builtin_amdgcn_readfirstlane(ntw);
    bf16x8 Qf[4];
    {
        const u16* qrow = (const u16*)(ws + WS_QB) + (size_t)(qtok0 + pair * 32 + r) * 768 + h * 128 + cm * 64 + hh * 8;
#pragma unroll
        for (int ks = 0; ks < 4; ++ks) {
            if (ntw > 0) Qf[ks] = *(const bf16x8*)(qrow + ks * 16);
            else Qf[ks] = (bf16x8){0, 0, 0, 0, 0, 0, 0, 0};
        }
    }
    f32x16 O[4];
#pragma unroll
    for (int d = 0; d < 4; ++d)
#pragma unroll
        for (int i = 0; i < 16; ++i) O[d][i] = 0.f;
    float m = 0.f, l = 0.f; bool shifted = false;

    const int krow = tid >> 4, kch = tid & 15;
    const int kdst = krow * 256 + ((kch ^ (krow & 15)) << 4);
    const rsrc_t kg = mkrsrc(kbase);
    const unsigned kvo = (unsigned)(krow * 1536 + kch * 16);
    const int vrow = tid >> 3, vch = tid & 7;
    const int vdst = 16384 + vrow * 128 + ((vch ^ ((vrow >> 1) & 7)) << 4);
    const rsrc_t vg = mkrsrc(vbase);
    const unsigned vvo = (unsigned)(vrow * vstride * 2 + vch * 16);
    const unsigned vstep = 128u * (unsigned)vstride;
    u32x4 rk[2], rv[2];
#pragma unroll
    for (int i = 0; i < 2; ++i) { rk[i] = bload(kg, kvo, i * 49152); rv[i] = bload(vg, vvo, i * vstep); }
#pragma unroll
    for (int i = 0; i < 2; ++i) { *(u32x4*)(smem + kdst + i * 8192) = rk[i]; *(u32x4*)(smem + vdst + i * 8192) = rv[i]; }
    __syncthreads();
    const int ksw = r & 15, vsw = (r >> 1) & 7;
    for (int t = 0; t < ntiles; ++t) {
        const int cur = (t & 1) * 32768, nxt = 32768 - cur;
        if (t + 1 < ntiles) {
#pragma unroll
            for (int i = 0; i < 2; ++i) { rk[i] = bload(kg, kvo, ((t + 1) * 64 + i * 32) * 1536); rv[i] = bload(vg, vvo, (t + 1) * 128 + i * vstep); }
        }
        if (t < ntw) {
            f32x16 S0, S1;
#pragma unroll
            for (int i = 0; i < 16; ++i) { S0[i] = 0.f; S1[i] = 0.f; }
            const int kro = cur + r * 256;
            __builtin_amdgcn_s_setprio(1);
#pragma unroll
            for (int ks = 0; ks < 4; ++ks) {
                const int co = ((cm * 8 + ks * 2 + hh) ^ ksw) << 4;
                const bf16x8 a0 = *(const bf16x8*)(smem + kro + co);
                const bf16x8 a1 = *(const bf16x8*)(smem + kro + 8192 + co);
                S0 = MFMA32(a0, Qf[ks], S0); S1 = MFMA32(a1, Qf[ks], S1);
            }
            __builtin_amdgcn_s_setprio(0);
            if (shifted) { S0 -= m; S1 -= m; }
            if (sample && t == ntiles - 1) {
#pragma unroll
                for (int i = 0; i < 16; ++i) S1[i] = -INFINITY;
            }
            float mxa = fmaxf(fmaxf(S0[0], S0[1]), S0[2]), mxb = fmaxf(fmaxf(S1[0], S1[1]), S1[2]);
#pragma unroll
            for (int i = 3; i < 15; i += 2) { mxa = fmaxf(fmaxf(mxa, S0[i]), S0[i + 1]); mxb = fmaxf(fmaxf(mxb, S1[i]), S1[i + 1]); }
            const float mx = fmaxf(fmaxf(mxa, S0[15]), fmaxf(mxb, S1[15]));
            const bool need = (mx > 16.0f) || (t == 0 && mx < -16.0f);
            if (__any(need)) {
                const u32x2 rr = __builtin_amdgcn_permlane32_swap(__float_as_uint(mx), __float_as_uint(mx), false, false);
                const float rmx = fmaxf(__uint_as_float(rr.x), __uint_as_float(rr.y));
                const float delta = ((rmx > 16.0f) || (t == 0 && rmx < -16.0f)) ? rmx : 0.0f;
                if (t > 0) {
                    const float alpha = __builtin_amdgcn_exp2f(-delta);
#pragma unroll
                    for (int d = 0; d < 4; ++d) O[d] *= alpha;
                    l *= alpha;
                }
                S0 -= delta; S1 -= delta; m += delta; shifted = true;
            }
            float ls0 = 0.f, ls1 = 0.f, ls2 = 0.f, ls3 = 0.f;
#pragma unroll
            for (int i = 0; i < 16; i += 2) {
                S0[i] = __builtin_amdgcn_exp2f(S0[i]); S1[i] = __builtin_amdgcn_exp2f(S1[i]); S0[i + 1] = __builtin_amdgcn_exp2f(S0[i + 1]); S1[i + 1] = __builtin_amdgcn_exp2f(S1[i + 1]);
                ls0 += S0[i]; ls1 += S1[i]; ls2 += S0[i + 1]; ls3 += S1[i + 1];
            }
            l += (ls0 + ls1) + (ls2 + ls3);
            bf16x8 Pf[4];
            {
                u32x4 q;
                q.x = pk(S0[0], S0[1]); q.y = pk(S0[2], S0[3]); q.z = pk(S0[4], S0[5]); q.w = pk(S0[6], S0[7]); Pf[0] = __builtin_bit_cast(bf16x8, q);
                q.x = pk(S0[8], S0[9]); q.y = pk(S0[10], S0[11]); q.z = pk(S0[12], S0[13]); q.w = pk(S0[14], S0[15]); Pf[1] = __builtin_bit_cast(bf16x8, q);
                q.x = pk(S1[0], S1[1]); q.y = pk(S1[2], S1[3]); q.z = pk(S1[4], S1[5]); q.w = pk(S1[6], S1[7]); Pf[2] = __builtin_bit_cast(bf16x8, q);
                q.x = pk(S1[8], S1[9]); q.y = pk(S1[10], S1[11]); q.z = pk(S1[12], S1[13]); q.w = pk(S1[14], S1[15]); Pf[3] = __builtin_bit_cast(bf16x8, q);
            }
            const int vro = cur + 16384 + r * 128;
            __builtin_amdgcn_s_setprio(1);
#pragma unroll
            for (int kk = 0; kk < 4; ++kk) {
                const int co = ((2 * kk + hh) ^ vsw) << 4;
#pragma unroll
                for (int d = 0; d < 4; ++d) {
                    const bf16x8 v = *(const bf16x8*)(smem + vro + d * 4096 + co);
                    O[d] = MFMA32(v, Pf[kk], O[d]);
                }
            }
            __builtin_amdgcn_s_setprio(0);
        }
        if (t + 1 < ntiles) {
#pragma unroll
            for (int i = 0; i < 2; ++i) { *(u32x4*)(smem + nxt + kdst + i * 8192) = rk[i]; *(u32x4*)(smem + nxt + vdst + i * 8192) = rv[i]; }
        }
        __syncthreads();
    }
    const float lt = l + __shfl_xor(l, 32);
    const float inv = 1.0f / lt;
    int xo = XOFF + pair * 16384 + lane * 4;
    LAUNDER(xo);
    if (cm == 1 && ntw > 0) {
        const float sc = lam * inv;
#pragma unroll
        for (int d = 0; d < 4; ++d)
#pragma unroll
            for (int i = 0; i < 16; ++i) *(float*)(smem + xo + (d * 16 + i) * 256) = O[d][i] * sc;
    }
    __syncthreads();
    if (cm == 0 && ntw > 0) {
        float ss = 0.f;
#pragma unroll
        for (int d = 0; d < 4; ++d)
#pragma unroll
            for (int i = 0; i < 16; ++i) { const float v = O[d][i] * inv - *(const float*)(smem + xo + (d * 16 + i) * 256); O[d][i] = v; ss += v * v; }
        asm volatile("" ::: "memory");
        ss += __shfl_xor(ss, 32);
        const float rstd = rsqrtf(ss * (1.0f / 128.0f) + 1e-5f) * 0.8f;
        int tok = qtok0 + pair * 32 + r, hh4 = 4 * hh;
        LAUNDER(tok); LAUNDER(hh4);
        const u16* ga = (const u16*)(ws + WS_GA) + (size_t)tok * 768 + h * 128;
        u16* mo = (u16*)(ws + WS_MIX) + (size_t)tok * 1024 + 256 + h * 128;
#pragma unroll
        for (int d = 0; d < 4; ++d)
#pragma unroll
            for (int j4 = 0; j4 < 4; ++j4) {
                const int d0 = d * 32 + 8 * j4 + hh4;
                const u32x2 g = *(const u32x2*)(ga + d0);
                const f32x4 sg = *(const f32x4*)(p.subln_g + d0);
                const float v0 = O[d][4 * j4] * rstd * sg.x * bf_lo(g.x), v1 = O[d][4 * j4 + 1] * rstd * sg.y * bf_hi(g.x);
                const float v2 = O[d][4 * j4 + 2] * rstd * sg.z * bf_lo(g.y), v3 = O[d][4 * j4 + 3] * rstd * sg.w * bf_hi(g.y);
                u32x2 o; o.x = pk(v0, v1); o.y = pk(v2, v3);
                *(u32x2*)(mo + d0) = o;
                if (j4 & 1) asm volatile("" ::: "memory");
            }
    }
}

DI void pool_unit(const Params& p, int tid, int pu) {
    const int lane = tid & 63, w = tid >> 6, r = lane & 31, hh = lane >> 5;
    unsigned char* ws = p.ws;
    const float* U = (const float*)(ws + WS_U);
    const int tok0 = pu * 32; const bool smp = tok0 >= NP;
    float* E = (float*)smem;
    u16* PA = (u16*)(smem + 49152);
#pragma unroll 1
    for (int i = tid; i < 47 * 64; i += 512) {
        const int row = i >> 6, c4 = (i & 63) * 4; f32x4 v;
        if (row < 15) {
            if (smp) v = *(const f32x4*)(p.state_pool + ((size_t)((tok0 - NP) >> 5) * 15 + row) * 256 + c4);
            else if ((tok0 & 16383) == 0) v = (f32x4){0.f, 0.f, 0.f, 0.f};
            else v = *(const f32x4*)(U + (size_t)(tok0 - 15 + row) * 256 + c4);
        } else v = *(const f32x4*)(U + (size_t)(tok0 + row - 15) * 256 + c4);
        *(f32x4*)(E + row * 256 + c4) = v;
    }
    __syncthreads();
    {
        const int c = tid & 255, th = tid >> 8, g = c >> 6, wdw = 2 << g, tin0 = tok0 & 16383;
#pragma unroll 1
        for (int tt = 0; tt < 16; ++tt) {
            const int t = th * 16 + tt; float s = 0.f;
#pragma unroll 2
            for (int i = 0; i < wdw; ++i) s += E[(15 + t - i) * 256 + c];
            const int cnt = smp ? wdw : min(wdw, tin0 + t + 1);
            const float pooled = s / (float)cnt - E[(15 + t) * 256 + c];
            PA[t * 264 + c] = bf1(pooled);
        }
    }
    __syncthreads();
    {
        const int g = w >> 1, nb = w & 1;
        const u16* pw = (const u16*)(ws + WS_PWT) + (size_t)(g * 64 + nb * 32 + r) * 64 + hh * 8;
        f32x16 acc;
#pragma unroll
        for (int i = 0; i < 16; ++i) acc[i] = 0.f;
#pragma unroll
        for (int ks = 0; ks < 4; ++ks) {
            const bf16x8 a = *(const bf16x8*)(PA + r * 264 + g * 64 + ks * 16 + hh * 8);
            const bf16x8 b = *(const bf16x8*)(pw + ks * 16);
            acc = MFMA32(a, b, acc);
        }
        const int col = g * 64 + nb * 32 + r; const float pb = p.pool_b[col], ps = p.pool_scale[col];
        const float* G = (const float*)(ws + WS_GP); u16* mo = (u16*)(ws + WS_MIX);
#pragma unroll
        for (int i = 0; i < 16; ++i) {
            const int tok = tok0 + (i & 3) + 8 * (i >> 2) + 4 * hh;
            mo[(size_t)tok * 1024 + col] = bf1((acc[i] + pb) * ps * G[(size_t)tok * 256 + col]);
        }
    }
    __syncthreads();
}

DI void phase2(const Params& p, int tid) {
    unsigned char* ws = p.ws;
    const int lane = tid & 63;
    const float sa = wave_sum(p.lq1[lane] * p.lk1[lane]), sb = wave_sum(p.lq2[lane] * p.lk2[lane]);
    const float lam = __expf(sa) - __expf(sb) + 0.2f;
    const u16* KB = (const u16*)(ws + WS_KB); const u16* VT = (const u16*)(ws + WS_VT);
    for (int pi = blockIdx.x; pi < 768; pi += gridDim.x) {
        int bh, j;
        if (gridDim.x == 256) { const int xcd = blockIdx.x & 7, slot = blockIdx.x >> 3, rnd = pi >> 8; bh = rnd * 4 + (xcd & 3); j = slot + 32 * (xcd >> 2); }
        else { bh = pi >> 6; j = pi & 63; }
        const int b = bh / 6, h = bh % 6;
        for (int half = 0; half < 2; ++half) {
            const int qb = half == 0 ? 127 - j : j;
            attn_unit(p, tid, b * SEQ + qb * 128, h, KB + (size_t)b * SEQ * 768 + h * 128, VT + (size_t)bh * 128 * SEQ, SEQ, 2 * qb + 2, false, lam);
        }
    }
    unsigned* ctrl = (unsigned*)(ws + WS_CTRL);
    const u16* KS = (const u16*)(ws + WS_KBS); const u16* VS = (const u16*)(ws + WS_VTS);
    for (;;) {
        if (tid == 0) *(volatile int*)(smem + LDS_SLOT) = (int)atomicAdd(ctrl, 1u);
        __syncthreads();
        const int u = *(volatile int*)(smem + LDS_SLOT);
        __syncthreads();
        if (u >= 48 + 1032) break;
        if (u < 48) {
            const int b = u / 6, h = u % 6;
            attn_unit(p, tid, NP + b * 32, h, KS + (size_t)b * SKV * 768 + h * 128, VS + (size_t)u * 128 * SKV, SKV, 17, true, lam);
        } else pool_unit(p, tid, u - 48);
    }
}

struct EpiOutProj {
    static constexpr bool PERM = false, AFTER_DRAIN = false;
    const float* xp; const float* xs; float* y; float* st;
    __device__ __forceinline__ void operator()(const pg8::f32x4 (&acc)[2][2][4][2], const pg8::Unit& u, int wr, int wc, int fr_, int fq_) const {
        int fr = fr_, fq = fq_; LAUNDER(fr); LAUNDER(fq);
        const int r0 = u.pm * 256 + wr * 64 + fr, c0 = u.pn * 256 + wc * 32 + 4 * fq;
#pragma unroll
        for (int ai = 0; ai < 2; ++ai)
#pragma unroll
            for (int m = 0; m < 4; ++m) {
                const int R = r0 + ai * 128 + m * 16;
                const float* xr = R < NP ? xp + (size_t)R * 1024 : xs + (size_t)(R - NP) * 1024;
                float* yr = y + (size_t)R * 1024;
                float s1 = 0.f, s2 = 0.f;
#pragma unroll
                for (int bj = 0; bj < 2; ++bj)
#pragma unroll
                    for (int n = 0; n < 2; ++n) {
                        const int C = c0 + bj * 128 + n * 16;
                        const f32x4 xv = *(const f32x4*)(xr + C);
                        const f32x4 z = xv * DN_ALPHA + acc[ai][bj][m][n];
                        *(f32x4*)(yr + C) = z;
                        s1 += (z.x + z.y) + (z.z + z.w); s2 += (z.x * z.x + z.y * z.y) + (z.z * z.z + z.w * z.w);
                    }
                s1 += __shfl_xor(s1, 16); s2 += __shfl_xor(s2, 16); s1 += __shfl_xor(s1, 32); s2 += __shfl_xor(s2, 32);
                if (fq == 0) { f32x2 pr; pr.x = s1; pr.y = s2; *(f32x2*)(st + ((size_t)R * 16 + u.pn * 4 + wc) * 2) = pr; }
                asm volatile("" ::: "memory");
            }
    }
};

DI void phase3a(const Params& p) {
    pg8::Gemm g{(const pg8::bf16_t*)(p.ws + WS_MIX), (const pg8::bf16_t*)(p.ws + WS_WTOUT), NT, 1024, 1024};
    pg8::StaticOrder S; S.init(NT, 1024, (int)gridDim.x, (int)blockIdx.x);
    EpiOutProj E{p.x_prompt, p.x_sample, p.out + O_YP, (float*)(p.ws + WS_ST)};
    pg8::gemm_phase<EpiOutProj, pg8::StaticOrder, true, true>((PG8_LAS unsigned char*)smem, g, S, E);
}

DI void phase3b(const Params& p, int tid) {
    const int lane = tid & 63, gw = blockIdx.x * 8 + (tid >> 6), nw = gridDim.x * 8;
    const float* st = (const float*)(p.ws + WS_ST);
    float* y = p.out + O_YP;
    f32x4 g[4], bb[4];
#pragma unroll
    for (int j = 0; j < 4; ++j) { g[j] = *(const f32x4*)(p.ln_g + j * 256 + lane * 4); bb[j] = *(const f32x4*)(p.ln_b + j * 256 + lane * 4); }
    for (int R0 = gw; R0 < NT; R0 += 2 * nw) {
        f32x4 z[2][4]; f32x2 pr[2];
#pragma unroll
        for (int k = 0; k < 2; ++k) {
            const int R = R0 + k * nw;
            if (R < NT) {
                pr[k] = *(const f32x2*)(st + ((size_t)R * 16 + (lane & 15)) * 2);
#pragma unroll
                for (int j = 0; j < 4; ++j) z[k][j] = *(const f32x4*)(y + (size_t)R * 1024 + j * 256 + lane * 4);
            }
        }
#pragma unroll
        for (int k = 0; k < 2; ++k) {
            const int R = R0 + k * nw;
            if (R < NT) {
                float s1 = pr[k].x, s2 = pr[k].y;
#pragma unroll
                for (int o = 8; o > 0; o >>= 1) { s1 += __shfl_xor(s1, o); s2 += __shfl_xor(s2, o); }
                const float mu = s1 * (1.0f / 1024.0f);
                const float var = fmaxf(s2 * (1.0f / 1024.0f) - mu * mu, 0.f);
                const float rstd = rsqrtf(var + 1e-5f);
#pragma unroll
                for (int j = 0; j < 4; ++j) *(f32x4*)(y + (size_t)R * 1024 + j * 256 + lane * 4) = (z[k][j] - mu) * rstd * g[j] + bb[j];
            }
        }
    }
}

__global__ void __launch_bounds__(512) fwd_kernel(Params p) {
    cg::grid_group grid = cg::this_grid();
    const int tid = threadIdx.x;
    phase0(p, tid);
    if (p.ws == nullptr) grid.sync();
    grid_barrier((unsigned*)(p.ws + WS_CTRL) + 192);
    phase1(p, tid);
    grid_barrier((unsigned*)(p.ws + WS_CTRL) + 64);
    phase2(p, tid);
    grid_barrier((unsigned*)(p.ws + WS_CTRL) + 128);
    phase3a(p);
    grid_barrier((unsigned*)(p.ws + WS_CTRL) + 256);
    phase3b(p, tid);
}

extern "C" void kernel_launch(void* const* d_in, const int* in_sizes, int n_in, void* d_out, int out_size, void* d_ws, size_t ws_size, hipStream_t stream) {
    static int grid = 0;
    if (grid == 0) {
        if (n_in != 17 || ws_size < WS_END) { fprintf(stderr, "kernel_launch: unexpected n_in %d / ws_size %zu (need %zu)\n", n_in, ws_size, (size_t)WS_END); grid = -1; return; }
        int dev = 0, cus = 0, per_cu = 0;
        hipGetDevice(&dev);
        hipDeviceGetAttribute(&cus, hipDeviceAttributeMultiprocessorCount, dev);
        if (hipFuncSetAttribute((const void*)fwd_kernel, hipFuncAttributeMaxDynamicSharedMemorySize, LDS_BYTES) != hipSuccess) { fprintf(stderr, "kernel_launch: hipFuncSetAttribute failed\n"); grid = -1; return; }
        if (hipOccupancyMaxActiveBlocksPerMultiprocessor(&per_cu, (const void*)fwd_kernel, 512, LDS_BYTES) != hipSuccess || per_cu < 1) { fprintf(stderr, "kernel_launch: occupancy query gave %d\n", per_cu); per_cu = 1; }
        (void)hipGetLastError();
        grid = cus * per_cu;
        fprintf(stderr, "kernel_launch: grid %d (cus %d x %d)\n", grid, cus, per_cu);
    }
    if (grid < 0) return;
    Params p{};
    p.x_prompt = (const float*)d_in[0]; p.x_sample = (const float*)d_in[1]; p.cache_k = (const float*)d_in[2]; p.cache_v = (const float*)d_in[3]; p.state_pool = (const float*)d_in[4];
    p.w_in = (const float*)d_in[5]; p.pool_w = (const float*)d_in[6]; p.pool_b = (const float*)d_in[7]; p.pool_scale = (const float*)d_in[8];
    p.lq1 = (const float*)d_in[9]; p.lk1 = (const float*)d_in[10]; p.lq2 = (const float*)d_in[11]; p.lk2 = (const float*)d_in[12]; p.subln_g = (const float*)d_in[13];
    p.w_out = (const float*)d_in[14]; p.ln_g = (const float*)d_in[15]; p.ln_b = (const float*)d_in[16];
    p.out = (float*)d_out; p.ws = (unsigned char*)d_ws;
    if (hipMemsetAsync((char*)d_ws + WS_CTRL, 0, 4096, stream) != hipSuccess) { fprintf(stderr, "kernel_launch: hipMemsetAsync failed\n"); return; }
    void* args[] = {&p};
    hipError_t e = hipLaunchCooperativeKernel((const void*)fwd_kernel, dim3(grid), dim3(512), args, LDS_BYTES, stream);
    if (e != hipSuccess) fprintf(stderr, "kernel_launch: cooperative launch failed: %s (grid %d)\n", hipGetErrorString(e), grid);
}
```

```cpp
#include <hip/hip_runtime.h>
#include <hip/hip_cooperative_groups.h>
#include <cstdio>
#include <cstdint>
namespace cg = cooperative_groups;

typedef short bf16x8 __attribute__((ext_vector_type(8)));
typedef float f32x16 __attribute__((ext_vector_type(16)));
typedef float f32x4 __attribute__((ext_vector_type(4)));
typedef float f32x2 __attribute__((ext_vector_type(2)));
typedef __bf16 bf16x2_t __attribute__((ext_vector_type(2)));
typedef unsigned u32x4 __attribute__((ext_vector_type(4)));
typedef unsigned u32x2 __attribute__((ext_vector_type(2)));
typedef unsigned short u16;

#define MFMA32(a, b, c) __builtin_amdgcn_mfma_f32_32x32x16_bf16((a), (b), (c), 0, 0, 0)
#define DI __device__ __forceinline__

constexpr int NP = 32768, NS = 256, NT = NP + NS;
constexpr int INW = 3584, SEQ = 16384, SKV = 1088;
constexpr int LDS_BYTES = 147456;
constexpr int LDS_SLOT = 147440;
constexpr int XOFF = 73728;

constexpr size_t WS_CTRL = 0;
constexpr size_t WS_XB = 4096;
constexpr size_t WS_WTIN = WS_XB + (size_t)NT * 1024 * 2;
constexpr size_t WS_WTOUT = WS_WTIN + (size_t)INW * 1024 * 2;
constexpr size_t WS_PWT = WS_WTOUT + (size_t)1024 * 1024 * 2;
constexpr size_t WS_U = WS_PWT + 32768;
constexpr size_t WS_GP = WS_U + (size_t)NT * 256 * 4;
constexpr size_t WS_QB = WS_GP + (size_t)NT * 256 * 4;
constexpr size_t WS_KB = WS_QB + (size_t)NT * 768 * 2;
constexpr size_t WS_KBS = WS_KB + (size_t)NP * 768 * 2;
constexpr size_t WS_VT = WS_KBS + (size_t)8 * SKV * 768 * 2;
constexpr size_t WS_VTS = WS_VT + (size_t)12 * 128 * SEQ * 2;
constexpr size_t WS_GA = WS_VTS + (size_t)48 * 128 * SKV * 2;
constexpr size_t WS_MIX = WS_GA + (size_t)NT * 768 * 2;
constexpr size_t WS_ST = WS_MIX + (size_t)NT * 1024 * 2;
constexpr size_t WS_END = WS_ST + (size_t)NT * 16 * 8;

constexpr size_t O_YP = 0, O_KP = 33816576, O_VP = 58982400, O_PP = 84148224, O_KS = 84155904, O_VS = 84352512, O_PS = 84549120;

constexpr float QSCALE = 0.125f * 1.4426950408889634f;
constexpr float DN_ALPHA = 1.189207115002721f;

struct Params {
    const float* x_prompt; const float* x_sample; const float* cache_k; const float* cache_v; const float* state_pool;
    const float* w_in; const float* pool_w; const float* pool_b; const float* pool_scale;
    const float* lq1; const float* lk1; const float* lq2; const float* lk2; const float* subln_g;
    const float* w_out; const float* ln_g; const float* ln_b;
    float* out; unsigned char* ws;
};

extern __shared__ __attribute__((aligned(16))) unsigned char smem[];

DI unsigned pk(float lo, float hi) { f32x2 v = {lo, hi}; bf16x2_t b = __builtin_convertvector(v, bf16x2_t); return __builtin_bit_cast(unsigned, b); }
DI u16 bf1(float x) { __bf16 b = (__bf16)x; return __builtin_bit_cast(u16, b); }
DI float bf_lo(unsigned w) { return __uint_as_float(w << 16); }
DI float bf_hi(unsigned w) { return __uint_as_float(w & 0xffff0000u); }
DI float silu(float v) { return v / (1.0f + __expf(-v)); }
DI float wave_sum(float v) {
#pragma unroll
    for (int o = 32; o > 0; o >>= 1) v += __shfl_xor(v, o);
    return v;
}
typedef __amdgpu_buffer_rsrc_t rsrc_t;
DI rsrc_t mkrsrc(const void* p) { return __builtin_amdgcn_make_buffer_rsrc((void*)p, 0, 0x7fffffff, 0x00020000); }
DI u32x4 bload(rsrc_t rs, unsigned voff, unsigned soff) { return __builtin_amdgcn_raw_buffer_load_b128(rs, voff, soff, 0); }
#define LAUNDER(x) asm volatile("" : "+v"(x))
DI int perm16(int s) { return (s & ~12) | ((s & 4) << 1) | ((s & 8) >> 1); }

DI void grid_barrier(unsigned* cnt) {
    __syncthreads();
    if (threadIdx.x == 0) {
        __builtin_amdgcn_fence(__ATOMIC_RELEASE, "agent");
        __hip_atomic_fetch_add(cnt, 1u, __ATOMIC_RELAXED, __HIP_MEMORY_SCOPE_AGENT);
        const unsigned want = gridDim.x;
        while (__hip_atomic_load(cnt, __ATOMIC_RELAXED, __HIP_MEMORY_SCOPE_AGENT) < want) __builtin_amdgcn_s_sleep(2);
        __builtin_amdgcn_fence(__ATOMIC_ACQUIRE, "agent");
    }
    __syncthreads();
}
DI void phase0(const Params& p, int tid) {
    unsigned char* ws = p.ws;
    const int wv = tid >> 6;
    if (wv < 4) {
        const size_t g0 = (size_t)blockIdx.x * 256 + tid, gs = (size_t)gridDim.x * 256;
        u16* xb = (u16*)(ws + WS_XB);
        const size_t N = (size_t)NT * 128;
        for (size_t i0 = g0; i0 < N; i0 += 4 * gs) {
            f32x4 a[4], b[4];
#pragma unroll
            for (int u = 0; u < 4; ++u) {
                const size_t i = i0 + u * gs;
                if (i < N) {
                    const size_t e = i * 8;
                    const float* s = e < (size_t)NP * 1024 ? p.x_prompt + e : p.x_sample + (e - (size_t)NP * 1024);
                    a[u] = *(const f32x4*)s; b[u] = *(const f32x4*)(s + 4);
                }
            }
#pragma unroll
            for (int u = 0; u < 4; ++u) {
                const size_t i = i0 + u * gs;
                if (i < N) {
                    u32x4 w; w.x = pk(a[u].x, a[u].y); w.y = pk(a[u].z, a[u].w); w.z = pk(b[u].x, b[u].y); w.w = pk(b[u].z, b[u].w);
                    *(u32x4*)(xb + i * 8) = w;
                }
            }
        }
    } else if (wv < 6) {
        const size_t g0 = (size_t)blockIdx.x * 128 + (tid - 256), gs = (size_t)gridDim.x * 128;
        {
            u16* wt = (u16*)(ws + WS_WTIN);
            for (size_t i = g0; i < (size_t)INW * 128; i += gs) {
                const int n = (int)(i % INW), k8 = (int)(i / INW);
                const float* s = p.w_in + (size_t)k8 * 8 * INW + n;
                float v[8];
#pragma unroll
                for (int j = 0; j < 8; ++j) v[j] = s[(size_t)j * INW];
                u32x4 w; w.x = pk(v[0], v[1]); w.y = pk(v[2], v[3]); w.z = pk(v[4], v[5]); w.w = pk(v[6], v[7]);
                *(u32x4*)(wt + (size_t)n * 1024 + k8 * 8) = w;
            }
        }
        {
            u16* wt = (u16*)(ws + WS_WTOUT);
            for (size_t i = g0; i < (size_t)1024 * 128; i += gs) {
                const int n = (int)(i & 1023), k8 = (int)(i >> 10);
                const float* s = p.w_out + (size_t)k8 * 8 * 1024 + n;
                float v[8];
#pragma unroll
                for (int j = 0; j < 8; ++j) v[j] = s[(size_t)j * 1024];
                u32x4 w; w.x = pk(v[0], v[1]); w.y = pk(v[2], v[3]); w.z = pk(v[4], v[5]); w.w = pk(v[6], v[7]);
                *(u32x4*)(wt + (size_t)n * 1024 + k8 * 8) = w;
            }
        }
        {
            u16* pw = (u16*)(ws + WS_PWT);
            for (size_t i = g0; i < 16384; i += gs) {
                const int g = (int)(i >> 12), d = (int)((i >> 6) & 63), c = (int)(i & 63);
                pw[i] = bf1(p.pool_w[g * 4096 + c * 64 + d]);
            }
        }
    } else {
        const size_t g0 = (size_t)blockIdx.x * 128 + (tid - 384), gs = (size_t)gridDim.x * 128;
        {
            u16* kb = (u16*)(ws + WS_KBS);
            const size_t NK = (size_t)8 * 1024 * 96;
            for (size_t i0 = g0; i0 < NK; i0 += 4 * gs) {
                f32x4 a[4], c[4];
#pragma unroll
                for (int u = 0; u < 4; ++u) { const size_t i = i0 + u * gs; if (i < NK) { const float* s = p.cache_k + i * 8; a[u] = *(const f32x4*)s; c[u] = *(const f32x4*)(s + 4); } }
#pragma unroll
                for (int u = 0; u < 4; ++u) {
                    const size_t i = i0 + u * gs;
                    if (i < NK) {
                        const size_t e = i * 8; const int b = (int)(e / (1024 * 768)); const int rem = (int)(e % (1024 * 768));
                        u32x4 w; w.x = pk(a[u].x, a[u].y); w.y = pk(a[u].z, a[u].w); w.z = pk(c[u].x, c[u].y); w.w = pk(c[u].z, c[u].w);
                        *(u32x4*)(kb + (size_t)b * SKV * 768 + rem) = w;
                    }
                }
            }
            for (size_t i = g0; i < (size_t)8 * 32 * 96; i += gs) {
                const int e = (int)i * 8; const int b = e / (32 * 768), rem = e % (32 * 768);
                u32x4 z = {0u, 0u, 0u, 0u};
                *(u32x4*)(kb + ((size_t)b * SKV + 1056) * 768 + rem) = z;
            }
        }
        {
            u16* vt = (u16*)(ws + WS_VTS);
            for (size_t i = g0; i < (size_t)48 * 64 * 128; i += gs) {
                const int d = (int)(i & 127), s16 = (int)((i >> 7) & 63), bh = (int)(i >> 13), b = bh / 6, h = bh % 6;
                const float* s = p.cache_v + ((size_t)(b * 1024 + s16 * 16) * 6 + h) * 128 + d;
                float v[16];
#pragma unroll
                for (int j = 0; j < 16; ++j) v[j] = s[(size_t)j * 768];
                u32x4 w0, w1;
                w0.x = pk(v[0], v[1]); w0.y = pk(v[2], v[3]); w0.z = pk(v[8], v[9]); w0.w = pk(v[10], v[11]);
                w1.x = pk(v[4], v[5]); w1.y = pk(v[6], v[7]); w1.z = pk(v[12], v[13]); w1.w = pk(v[14], v[15]);
                u16* dst = vt + ((size_t)bh * 128 + d) * SKV + s16 * 16;
                *(u32x4*)dst = w0; *(u32x4*)(dst + 8) = w1;
            }
            for (size_t i = g0; i < (size_t)48 * 128 * 4; i += gs) {
                u32x4 z = {0u, 0u, 0u, 0u};
                *(u32x4*)(vt + (i >> 2) * SKV + 1056 + (i & 3) * 8) = z;
            }
        }
    }
}

template <int MB, int NB, bool FENCE = false>
DI void mma_ktile(int aoff, int boff, int r, int hh, f32x16 (&acc)[MB][NB]) {
    const int sw = (r >> 1) & 7;
#pragma unroll
    for (int ks = 0; ks < 4; ++ks) {
        if (FENCE && (ks > 0)) __builtin_amdgcn_sched_barrier(0);
        const int co = ((2 * ks + hh) ^ sw) << 4;
        bf16x8 a[MB], b[NB];
#pragma unroll
        for (int mb = 0; mb < MB; ++mb) a[mb] = *(const bf16x8*)(smem + aoff + (mb * 32 + r) * 128 + co);
#pragma unroll
        for (int nb = 0; nb < NB; ++nb) b[nb] = *(const bf16x8*)(smem + boff + (nb * 32 + r) * 128 + co);
#pragma unroll
        for (int mb = 0; mb < MB; ++mb)
#pragma unroll
            for (int nb = 0; nb < NB; ++nb) acc[mb][nb] = MFMA32(a[mb], b[nb], acc[mb][nb]);
    }
}

namespace pg8 {
#define PG8_LAS __attribute__((address_space(3)))
typedef unsigned short bf16_t;
typedef short bf16x8 __attribute__((ext_vector_type(8)));
typedef float f32x4 __attribute__((ext_vector_type(4)));
typedef unsigned u32x4 __attribute__((ext_vector_type(4)));
constexpr int BM = 256, BK = 64, HALF = 128, HTB = HALF * BK * 2  , STAGE_BYTES = 8 * HTB, NXCD = 8, WGM = 8;

__host__ __device__ __forceinline__ int lds_byte(int r, int c) { const int st = (r >> 4) * 2 + (c >> 5), rr = r & 15, cc = c & 31, ob = rr * 64 + cc * 2; return st * 1024 + (ob ^ (((ob >> 9) & 1) << 5)); }
__host__ __device__ __forceinline__ void stage_rc(int b, int& R, int& C) { const int st = b / 1024, sb = b % 1024, swz = sb ^ (((sb >> 9) & 1) << 5); R = (st >> 1) * 16 + swz / 64; C = (st & 1) * 32 + (swz % 64) / 2; }
__host__ __device__ __forceinline__ int perm32(int rho) { const int n = rho >> 4, i = rho & 15; return 8 * (i >> 2) + 4 * n + (i & 3); }

struct Unit { int pm, pn; };
struct Gemm { const bf16_t* A; const bf16_t* Bt; int M, N, K; };

struct StaticOrder {
    int nM, nN, nwg, G, c;
    __host__ __device__ void init(int M, int N, int G_, int c_) { nM = M / BM; nN = N / BM; nwg = nM * nN; G = G_; c = c_; }
    __host__ __device__ bool next(int i, Unit& u) const {
        const long L = (long)i * G + c; if (L >= nwg) return false;
        int wgid = (int)L; { const int q = nwg / NXCD, r = nwg % NXCD, xcd = wgid % NXCD, off = wgid / NXCD; wgid = (xcd < r ? xcd * (q + 1) : r * (q + 1) + (xcd - r) * q) + off; }
        const int nig = WGM * nN, gid = wgid / nig, fm = gid * WGM, gsz = (nM - fm) < WGM ? (nM - fm) : WGM;
        u.pm = fm + ((wgid % nig) % gsz); u.pn = (wgid % nig) / gsz; return true;
    }
    __device__ __forceinline__ void a_ready(const Unit&) const {}
    __device__ __forceinline__ void done(const Unit&) const {}
};

typedef float f32x2 __attribute__((ext_vector_type(2)));
template <class Epi, class Sched, bool ALIGN_EPI = false, bool SP2 = false>
__device__ __forceinline__ void gemm_phase(PG8_LAS unsigned char* lds, const Gemm g, const Sched& S, const Epi& E) {
    const int tid = threadIdx.x, wid = __builtin_amdgcn_readfirstlane(tid >> 6), lane = tid & 63, wr = wid >> 2, wc = wid & 3, fr = lane & 15, fq = lane >> 4;
    const int K = g.K, nt = K / BK;
    unsigned voffA[2], voffB[2];
#pragma unroll
    for (int i = 0; i < 2; ++i) { int R, C; stage_rc(tid * 16 + i * 8192, R, C); const int Rb = Epi::PERM ? ((R & ~31) + perm32(R & 31)) : R;
        voffA[i] = (unsigned)(R * K + C) * 2u; voffB[i] = (unsigned)(Rb * K + C) * 2u; }
    const size_t kstep = (size_t)(BK * 2);
    const size_t hstep = (size_t)HALF * K * 2;
    const size_t tstep = 2 * hstep;
    const unsigned ldsw = (unsigned)wid * 1024u;
    const int aoff = lds_byte(wr * 64 + fr, fq * 8), boff = lds_byte(wc * 32 + fr, fq * 8);
#define PG8_SA(b, h) (((b) * 2 + (h)) * HTB)
#define PG8_SB(b, h) ((4 + (b) * 2 + (h)) * HTB)
#define PG8_STAGE(bufoff, gbase, voff) do { _Pragma("unroll") for (int _i = 0; _i < 2; ++_i) \
        __builtin_amdgcn_global_load_lds((const unsigned*)((const char*)(gbase) + (voff)[_i]), (PG8_LAS unsigned*)(lds + (bufoff) + ldsw + _i * 8192), 16, 0, 0); } while (0)
#define PG8_LDA(dst, b, h) do { _Pragma("unroll") for (int m = 0; m < 4; ++m) _Pragma("unroll") for (int k = 0; k < 2; ++k) dst[m][k] = *(const PG8_LAS bf16x8*)(lds + PG8_SA(b, h) + aoff + m * 2048 + k * 1024); } while (0)
#define PG8_LDB(dst, b, h) do { _Pragma("unroll") for (int n = 0; n < 2; ++n) _Pragma("unroll") for (int k = 0; k < 2; ++k) dst[n][k] = *(const PG8_LAS bf16x8*)(lds + PG8_SB(b, h) + boff + n * 2048 + k * 1024); } while (0)
#define PG8_MMA(ai, bj, At, Bt) do { __builtin_amdgcn_s_setprio(1); _Pragma("unroll") for (int m = 0; m < 4; ++m) _Pragma("unroll") for (int n = 0; n < 2; ++n) _Pragma("unroll") for (int k = 0; k < 2; ++k) \
        acc[ai][bj][m][n] = __builtin_amdgcn_mfma_f32_16x16x32_bf16(Bt[n][k], At[m][k], acc[ai][bj][m][n], 0, 0, 0); __builtin_amdgcn_s_setprio(0); } while (0)
#define PG8_WAIT_V(n) asm volatile("s_waitcnt vmcnt(" #n ")" ::: "memory")
#define PG8_WAIT_L(n) asm volatile("s_waitcnt lgkmcnt(" #n ")" ::: "memory")
#define PG8_BAR __builtin_amdgcn_s_barrier()
#define PG8_SCHED __builtin_amdgcn_sched_barrier(0)
    Unit cur, nxt; int ui = 0;
    if (!S.next(0, cur)) return;
    f32x4 acc[2][2][4][2];
#pragma unroll
    for (int a = 0; a < 2; ++a)
#pragma unroll
        for (int b = 0; b < 2; ++b)
#pragma unroll
            for (int m = 0; m < 4; ++m)
#pragma unroll
                for (int n = 0; n < 2; ++n) acc[a][b][m][n] = (f32x4){0.f, 0.f, 0.f, 0.f};
    bf16x8 At[4][2], B0[2][2], B1[2][2];
    const char* cA = (const char*)g.A + (size_t)cur.pm * tstep; const char* cB = (const char*)g.Bt + (size_t)cur.pn * tstep;
    S.a_ready(cur);
    if constexpr (SP2) {
        PG8_STAGE(PG8_SB(0, 0), cB, voffB); PG8_STAGE(PG8_SB(0, 1), cB + hstep, voffB); PG8_STAGE(PG8_SA(0, 0), cA, voffA); PG8_STAGE(PG8_SA(0, 1), cA + hstep, voffA);
        if (wr == 1) PG8_BAR;
        PG8_WAIT_V(2); PG8_BAR;
        PG8_STAGE(PG8_SB(1, 0), cB + kstep, voffB); PG8_STAGE(PG8_SA(1, 0), cA + kstep, voffA); PG8_STAGE(PG8_SB(1, 1), cB + hstep + kstep, voffB);
        PG8_WAIT_V(6); PG8_BAR;
    } else {
        PG8_STAGE(PG8_SB(0, 0), cB, voffB); PG8_STAGE(PG8_SA(0, 0), cA, voffA); PG8_STAGE(PG8_SB(0, 1), cB + hstep, voffB); PG8_STAGE(PG8_SA(0, 1), cA + hstep, voffA);
        if (wr == 1) PG8_BAR;
        PG8_WAIT_V(4); PG8_BAR;
        PG8_STAGE(PG8_SB(1, 0), cB + kstep, voffB); PG8_STAGE(PG8_SA(1, 0), cA + kstep, voffA); PG8_STAGE(PG8_SB(1, 1), cB + hstep + kstep, voffB);
        PG8_WAIT_V(6); PG8_BAR;
    }
    for (;;) {
        const bool has_next = S.next(ui + 1, nxt);
        const char* nA = has_next ? (const char*)g.A + (size_t)nxt.pm * tstep : cA; const char* nB = has_next ? (const char*)g.Bt + (size_t)nxt.pn * tstep : cB;
        for (int t = 0; t < nt; t += 2) {
            const bool last = (t == nt - 2);
            const char* a1 = cA + (size_t)(t + 1) * kstep;
            const char* a2 = last ? nA : cA + (size_t)(t + 2) * kstep; const char* b2 = last ? nB : cB + (size_t)(t + 2) * kstep;
            const char* a3 = a2 + kstep; const char* b3 = b2 + kstep;
            if (last && has_next) S.a_ready(nxt);
            if constexpr (SP2) {
            PG8_LDB(B0, 0, 0); PG8_LDB(B1, 0, 1); PG8_SCHED; PG8_LDA(At, 0, 0); PG8_STAGE(PG8_SA(1, 1), a1 + hstep, voffA);
            PG8_WAIT_V(8); PG8_WAIT_L(0); PG8_BAR; PG8_MMA(0, 0, At, B0); PG8_MMA(0, 1, At, B1); PG8_BAR; PG8_SCHED;
            PG8_LDA(At, 0, 1); PG8_STAGE(PG8_SB(0, 0), b2, voffB); PG8_STAGE(PG8_SB(0, 1), b2 + hstep, voffB); PG8_STAGE(PG8_SA(0, 0), a2, voffA);
            PG8_WAIT_V(8); PG8_WAIT_L(0); PG8_BAR; PG8_MMA(1, 0, At, B0); PG8_MMA(1, 1, At, B1); PG8_BAR; PG8_SCHED;
            PG8_LDB(B0, 1, 0); PG8_LDB(B1, 1, 1); PG8_SCHED; PG8_LDA(At, 1, 0); PG8_STAGE(PG8_SA(0, 1), a2 + hstep, voffA);
            PG8_WAIT_V(8); PG8_WAIT_L(0); PG8_BAR; PG8_MMA(0, 0, At, B0); PG8_MMA(0, 1, At, B1); PG8_BAR; PG8_SCHED;
            PG8_LDA(At, 1, 1); PG8_STAGE(PG8_SB(1, 0), b3, voffB); PG8_STAGE(PG8_SB(1, 1), b3 + hstep, voffB); PG8_STAGE(PG8_SA(1, 0), a3, voffA);
            PG8_WAIT_V(8); PG8_WAIT_L(0); PG8_BAR; PG8_MMA(1, 0, At, B0); PG8_MMA(1, 1, At, B1); PG8_BAR; PG8_SCHED;
            } else {
            PG8_LDB(B0, 0, 0); PG8_SCHED; PG8_LDA(At, 0, 0); PG8_STAGE(PG8_SA(1, 1), a1 + hstep, voffA);
            PG8_WAIT_L(8); PG8_BAR; PG8_WAIT_L(0); PG8_MMA(0, 0, At, B0); PG8_BAR; PG8_SCHED;
            PG8_LDB(B1, 0, 1); PG8_STAGE(PG8_SB(0, 0), b2, voffB);
            PG8_BAR; PG8_WAIT_L(0); PG8_MMA(0, 1, At, B1); PG8_BAR;
            PG8_LDA(At, 0, 1); PG8_STAGE(PG8_SA(0, 0), a2, voffA);
            PG8_BAR; PG8_WAIT_L(0); PG8_MMA(1, 0, At, B0); PG8_BAR; PG8_SCHED;
            PG8_STAGE(PG8_SB(0, 1), b2 + hstep, voffB);
            PG8_WAIT_V(6); PG8_BAR; PG8_MMA(1, 1, At, B1); PG8_BAR;
            PG8_LDB(B0, 1, 0); PG8_SCHED; PG8_LDA(At, 1, 0); PG8_STAGE(PG8_SA(0, 1), a2 + hstep, voffA);
            PG8_WAIT_L(8); PG8_BAR; PG8_WAIT_L(0); PG8_MMA(0, 0, At, B0); PG8_BAR; PG8_SCHED;
            PG8_LDB(B1, 1, 1); PG8_STAGE(PG8_SB(1, 0), b3, voffB);
            PG8_BAR; PG8_WAIT_L(0); PG8_MMA(0, 1, At, B1); PG8_BAR;
            PG8_LDA(At, 1, 1); PG8_STAGE(PG8_SA(1, 0), a3, voffA);
            PG8_BAR; PG8_WAIT_L(0); PG8_MMA(1, 0, At, B0); PG8_BAR; PG8_SCHED;
            PG8_STAGE(PG8_SB(1, 1), b3 + hstep, voffB);
            PG8_WAIT_V(6); PG8_BAR; PG8_MMA(1, 1, At, B1); PG8_BAR;
            }
        }
        if constexpr (ALIGN_EPI) { if (wr == 0) PG8_BAR; }
        if constexpr (!Epi::AFTER_DRAIN) { E(acc, cur, wr, wc, fr, fq); S.done(cur); }
        if (!has_next) break;
#pragma unroll
        for (int a = 0; a < 2; ++a)
#pragma unroll
            for (int b = 0; b < 2; ++b)
#pragma unroll
                for (int m = 0; m < 4; ++m)
#pragma unroll
                    for (int n = 0; n < 2; ++n) acc[a][b][m][n] = (f32x4){0.f, 0.f, 0.f, 0.f};
        cur = nxt; cA = nA; cB = nB; ++ui;
        if constexpr (ALIGN_EPI) { if (wr == 1) PG8_BAR; }
    }
    PG8_WAIT_V(0);
    if constexpr (!ALIGN_EPI) { if (wr == 0) PG8_BAR; }
    PG8_BAR;
    if constexpr (Epi::AFTER_DRAIN) { E.fused(acc, cur, wr, wc, fr, fq, lds, wid, lane); S.done(cur); }
#undef PG8_SA
#undef PG8_SB
#undef PG8_STAGE
#undef PG8_LDA
#undef PG8_LDB
#undef PG8_MMA
#undef PG8_WAIT_V
#undef PG8_WAIT_L
#undef PG8_BAR
#undef PG8_SCHED
}
}

struct EpiInProj {
    static constexpr bool PERM = false, AFTER_DRAIN = false;
    unsigned char* ws; float* out;
    __device__ __forceinline__ void operator()(const pg8::f32x4 (&acc)[2][2][4][2], const pg8::Unit& u, int wr, int wc, int fr_, int fq_) const {
        int fr = fr_, fq = fq_; LAUNDER(fr); LAUNDER(fq);
        const int pm = u.pm, pn = u.pn; const bool smp = (pm == 128);
        const int r0 = pm * 256 + wr * 64 + fr, c0 = wc * 32 + 4 * fq;
#pragma unroll
        for (int ai = 0; ai < 2; ++ai)
#pragma unroll
            for (int m = 0; m < 4; ++m) {
                const int R = r0 + ai * 128 + m * 16;
#pragma unroll
                for (int bj = 0; bj < 2; ++bj)
#pragma unroll
                    for (int n = 0; n < 2; ++n) {
                        const int ct = c0 + bj * 128 + n * 16;
                        const f32x4 v = acc[ai][bj][m][n];
                        if (pn == 0) {
                            *(f32x4*)((float*)(ws + WS_U) + (size_t)R * 256 + ct) = v;
                            if (!smp) { const int t = R & 16383; if (t >= 16369) *(f32x4*)(out + O_PP + (size_t)((R >> 14) * 15 + (t - 16369)) * 256 + ct) = v; }
                            else { const int rs = R - NP, t = rs & 31; if (t >= 17) *(f32x4*)(out + O_PS + (size_t)((rs >> 5) * 15 + (t - 17)) * 256 + ct) = v; }
                        } else if (pn == 1) {
                            f32x4 g; g.x = silu(v.x); g.y = silu(v.y); g.z = silu(v.z); g.w = silu(v.w);
                            *(f32x4*)((float*)(ws + WS_GP) + (size_t)R * 256 + ct) = g;
                        } else if (pn < 5) {
                            u32x2 q; q.x = pk(v.x * QSCALE, v.y * QSCALE); q.y = pk(v.z * QSCALE, v.w * QSCALE);
                            *(u32x2*)((u16*)(ws + WS_QB) + (size_t)R * 768 + (pn - 2) * 256 + ct) = q;
                        } else if (pn < 8) {
                            const int cc = (pn - 5) * 256 + ct;
                            u32x2 q; q.x = pk(v.x, v.y); q.y = pk(v.z, v.w);
                            if (!smp) { *(f32x4*)(out + O_KP + (size_t)R * 768 + cc) = v; *(u32x2*)((u16*)(ws + WS_KB) + (size_t)R * 768 + cc) = q; }
                            else { const int rs = R - NP; *(f32x4*)(out + O_KS + (size_t)rs * 768 + cc) = v; *(u32x2*)((u16*)(ws + WS_KBS) + ((size_t)(rs >> 5) * SKV + 1024 + (rs & 31)) * 768 + cc) = q; }
                        } else if (pn < 11) {
                            const int cc = (pn - 8) * 256 + ct, h = cc >> 7, d = cc & 127;
                            if (!smp) {
                                *(f32x4*)(out + O_VP + (size_t)R * 768 + cc) = v;
                                const int b = R >> 14, sq = R & 16383;
                                u16* vt = (u16*)(ws + WS_VT) + ((size_t)(b * 6 + h) * 128 + d) * SEQ + perm16(sq);
                                vt[0] = bf1(v.x); vt[SEQ] = bf1(v.y); vt[2 * SEQ] = bf1(v.z); vt[3 * SEQ] = bf1(v.w);
                            } else {
                                const int rs = R - NP;
                                *(f32x4*)(out + O_VS + (size_t)rs * 768 + cc) = v;
                                u16* vt = (u16*)(ws + WS_VTS) + ((size_t)((rs >> 5) * 6 + h) * 128 + d) * SKV + 1024 + perm16(rs & 31);
                                vt[0] = bf1(v.x); vt[SKV] = bf1(v.y); vt[2 * SKV] = bf1(v.z); vt[3 * SKV] = bf1(v.w);
                            }
                        } else {
                            u32x2 q; q.x = pk(silu(v.x), silu(v.y)); q.y = pk(silu(v.z), silu(v.w));
                            *(u32x2*)((u16*)(ws + WS_GA) + (size_t)R * 768 + (pn - 11) * 256 + ct) = q;
                        }
                    }
                asm volatile("" ::: "memory");
            }
    }
};

DI void phase1(const Params& p, int tid) {
    (void)tid;
    pg8::Gemm g{(const pg8::bf16_t*)(p.ws + WS_XB), (const pg8::bf16_t*)(p.ws + WS_WTIN), NT, INW, 1024};
    pg8::StaticOrder S; S.init(NT, INW, (int)gridDim.x, (int)blockIdx.x);
    EpiInProj E{p.ws, p.out};
    pg8::gemm_phase<EpiInProj, pg8::StaticOrder, true, true>((PG8_LAS unsigned char*)smem, g, S, E);
}

DI void attn_unit(const Params& p, int tid, int qtok0, int h, const u16* kbase, const u16* vbase, int vstride, int ntiles, bool sample, float lam) {
    const int lane = tid & 63, w = tid >> 6, r = lane & 31, hh = lane >> 5, pair = w >> 1, cm = w & 1;
    unsigned char* ws = p.ws;
    int ntw = sample ? (pair == 0 ? ntiles : 0) : (ntiles - 1 + (pair >> 1));
    ntw = __builtin_amdgcn_readfirstlane(ntw);
    bf16x8 Qf[4];
    {
        const u16* qrow = (const u16*)(ws + WS_QB) + (size_t)(qtok0 + pair * 32 + r) * 768 + h * 128 + cm * 64 + hh * 8;
#pragma unroll
        for (int ks = 0; ks < 4; ++ks) {
            if (ntw > 0) Qf[ks] = *(const bf16x8*)(qrow + ks * 16);
            else Qf[ks] = (bf16x8){0, 0, 0, 0, 0, 0, 0, 0};
        }
    }
    f32x16 O[4];
#pragma unroll
    for (int d = 0; d < 4; ++d)
#pragma unroll
        for (int i = 0; i < 16; ++i) O[d][i] = 0.f;
    float m = 0.f, l = 0.f; bool shifted = false;

    const int krow = tid >> 4, kch = tid & 15;
    const int kdst = krow * 256 + ((kch ^ (krow & 15)) << 4);
    const rsrc_t kg = mkrsrc(kbase);
    const unsigned kvo = (unsigned)(krow * 1536 + kch * 16);
    const int vrow = tid >> 3, vch = tid & 7;
    const int vdst = 16384 + vrow * 128 + ((vch ^ ((vrow >> 1) & 7)) << 4);
    const rsrc_t vg = mkrsrc(vbase);
    const unsigned vvo = (unsigned)(vrow * vstride * 2 + vch * 16);
    const unsigned vstep = 128u * (unsigned)vstride;
    u32x4 rk[2], rv[2];
#pragma unroll
    for (int i = 0; i < 2; ++i) { rk[i] = bload(kg, kvo, i * 49152); rv[i] = bload(vg, vvo, i * vstep); }
#pragma unroll
    for (int i = 0; i < 2; ++i) { *(u32x4*)(smem + kdst + i * 8192) = rk[i]; *(u32x4*)(smem + vdst + i * 8192) = rv[i]; }
    __syncthreads();
    const int ksw = r & 15, vsw = (r >> 1) & 7;
    for (int t = 0; t < ntiles; ++t) {
        const int cur = (t & 1) * 32768, nxt = 32768 - cur;
        if (t + 1 < ntiles) {
#pragma unroll
            for (int i = 0; i < 2; ++i) { rk[i] = bload(kg, kvo, ((t + 1) * 64 + i * 32) * 1536); rv[i] = bload(vg, vvo, (t + 1) * 128 + i * vstep); }
        }
        if (t < ntw) {
            f32x16 S0, S1;
#pragma unroll
            for (int i = 0; i < 16; ++i) { S0[i] = 0.f; S1[i] = 0.f; }
            const int kro = cur + r * 256;
            __builtin_amdgcn_s_setprio(1);
#pragma unroll
            for (int ks = 0; ks < 4; ++ks) {
                const int co = ((cm * 8 + ks * 2 + hh) ^ ksw) << 4;
                const bf16x8 a0 = *(const bf16x8*)(smem + kro + co);
                const bf16x8 a1 = *(const bf16x8*)(smem + kro + 8192 + co);
                S0 = MFMA32(a0, Qf[ks], S0); S1 = MFMA32(a1, Qf[ks], S1);
            }
            __builtin_amdgcn_s_setprio(0);
            if (shifted) { S0 -= m; S1 -= m; }
            if (sample && t == ntiles - 1) {
#pragma unroll
                for (int i = 0; i < 16; ++i) S1[i] = -INFINITY;
            }
            float mxa = fmaxf(fmaxf(S0[0], S0[1]), S0[2]), mxb = fmaxf(fmaxf(S1[0], S1[1]), S1[2]);
#pragma unroll
            for (int i = 3; i < 15; i += 2) { mxa = fmaxf(fmaxf(mxa, S0[i]), S0[i + 1]); mxb = fmaxf(fmaxf(mxb, S1[i]), S1[i + 1]); }
            const float mx = fmaxf(fmaxf(mxa, S0[15]), fmaxf(mxb, S1[15]));
            const bool need = (mx > 16.0f) || (t == 0 && mx < -16.0f);
            if (__any(need)) {
                const u32x2 rr = __builtin_amdgcn_permlane32_swap(__float_as_uint(mx), __float_as_uint(mx), false, false);
                const float rmx = fmaxf(__uint_as_float(rr.x), __uint_as_float(rr.y));
                const float delta = ((rmx > 16.0f) || (t == 0 && rmx < -16.0f)) ? rmx : 0.0f;
                if (t > 0) {
                    const float alpha = __builtin_amdgcn_exp2f(-delta);
#pragma unroll
                    for (int d = 0; d < 4; ++d) O[d] *= alpha;
                    l *= alpha;
                }
                S0 -= delta; S1 -= delta; m += delta; shifted = true;
            }
            float ls0 = 0.f, ls1 = 0.f, ls2 = 0.f, ls3 = 0.f;
#pragma unroll
            for (int i = 0; i < 16; i += 2) {
                float e0 = __builtin_amdgcn_exp2f(S0[i]), e1 = __builtin_amdgcn_exp2f(S1[i]), e2 = __builtin_amdgcn_exp2f(S0[i + 1]), e3 = __builtin_amdgcn_exp2f(S1[i + 1]);
                asm("" : "+v"(e0)); asm("" : "+v"(e1)); asm("" : "+v"(e2)); asm("" : "+v"(e3));
                S0[i] = e0; S1[i] = e1; S0[i + 1] = e2; S1[i + 1] = e3;
                ls0 += e0; ls1 += e1; ls2 += e2; ls3 += e3;
            }
            l += (ls0 + ls1) + (ls2 + ls3);
            bf16x8 Pf[4];
            {
                u32x4 q;
                q.x = pk(S0[0], S0[1]); q.y = pk(S0[2], S0[3]); q.z = pk(S0[4], S0[5]); q.w = pk(S0[6], S0[7]); Pf[0] = __builtin_bit_cast(bf16x8, q);
                q.x = pk(S0[8], S0[9]); q.y = pk(S0[10], S0[11]); q.z = pk(S0[12], S0[13]); q.w = pk(S0[14], S0[15]); Pf[1] = __builtin_bit_cast(bf16x8, q);
                q.x = pk(S1[0], S1[1]); q.y = pk(S1[2], S1[3]); q.z = pk(S1[4], S1[5]); q.w = pk(S1[6], S1[7]); Pf[2] = __builtin_bit_cast(bf16x8, q);
                q.x = pk(S1[8], S1[9]); q.y = pk(S1[10], S1[11]); q.z = pk(S1[12], S1[13]); q.w = pk(S1[14], S1[15]); Pf[3] = __builtin_bit_cast(bf16x8, q);
            }
            const int vro = cur + 16384 + r * 128;
            __builtin_amdgcn_s_setprio(1);
#pragma unroll
            for (int kk = 0; kk < 4; ++kk) {
                const int co = ((2 * kk + hh) ^ vsw) << 4;
#pragma unroll
                for (int d = 0; d < 4; ++d) {
                    const bf16x8 v = *(const bf16x8*)(smem + vro + d * 4096 + co);
                    O[d] = MFMA32(v, Pf[kk], O[d]);
                }
            }
            __builtin_amdgcn_s_setprio(0);
        }
        if (t + 1 < ntiles) {
#pragma unroll
            for (int i = 0; i < 2; ++i) { *(u32x4*)(smem + nxt + kdst + i * 8192) = rk[i]; *(u32x4*)(smem + nxt + vdst + i * 8192) = rv[i]; }
        }
        __syncthreads();
    }
    const float lt = l + __shfl_xor(l, 32);
    const float inv = 1.0f / lt;
    int xo = XOFF + pair * 16384 + lane * 4;
    LAUNDER(xo);
    if (cm == 1 && ntw > 0) {
        const float sc = lam * inv;
#pragma unroll
        for (int d = 0; d < 4; ++d)
#pragma unroll
            for (int i = 0; i < 16; ++i) *(float*)(smem + xo + (d * 16 + i) * 256) = O[d][i] * sc;
    }
    __syncthreads();
    if (cm == 0 && ntw > 0) {
        float ss = 0.f;
#pragma unroll
        for (int d = 0; d < 4; ++d)
#pragma unroll
            for (int i = 0; i < 16; ++i) { const float v = O[d][i] * inv - *(const float*)(smem + xo + (d * 16 + i) * 256); O[d][i] = v; ss += v * v; }
        asm volatile("" ::: "memory");
        ss += __shfl_xor(ss, 32);
        const float rstd = rsqrtf(ss * (1.0f / 128.0f) + 1e-5f) * 0.8f;
        int tok = qtok0 + pair * 32 + r, hh4 = 4 * hh;
        LAUNDER(tok); LAUNDER(hh4);
        const u16* ga = (const u16*)(ws + WS_GA) + (size_t)tok * 768 + h * 128;
        u16* mo = (u16*)(ws + WS_MIX) + (size_t)tok * 1024 + 256 + h * 128;
#pragma unroll
        for (int d = 0; d < 4; ++d)
#pragma unroll
            for (int j4 = 0; j4 < 4; ++j4) {
                const int d0 = d * 32 + 8 * j4 + hh4;
                const u32x2 g = *(const u32x2*)(ga + d0);
                const f32x4 sg = *(const f32x4*)(p.subln_g + d0);
                const float v0 = O[d][4 * j4] * rstd * sg.x * bf_lo(g.x), v1 = O[d][4 * j4 + 1] * rstd * sg.y * bf_hi(g.x);
                const float v2 = O[d][4 * j4 + 2] * rstd * sg.z * bf_lo(g.y), v3 = O[d][4 * j4 + 3] * rstd * sg.w * bf_hi(g.y);
                u32x2 o; o.x = pk(v0, v1); o.y = pk(v2, v3);
                *(u32x2*)(mo + d0) = o;
                if (j4 & 1) asm volatile("" ::: "memory");
            }
    }
}

DI void pool_unit(const Params& p, int tid, int pu) {
    const int lane = tid & 63, w = tid >> 6, r = lane & 31, hh = lane >> 5;
    unsigned char* ws = p.ws;
    const float* U = (const float*)(ws + WS_U);
    const int tok0 = pu * 32; const bool smp = tok0 >= NP;
    float* E = (float*)smem;
    u16* PA = (u16*)(smem + 49152);
#pragma unroll 1
    for (int i = tid; i < 47 * 64; i += 512) {
        const int row = i >> 6, c4 = (i & 63) * 4; f32x4 v;
        if (row < 15) {
            if (smp) v = *(const f32x4*)(p.state_pool + ((size_t)((tok0 - NP) >> 5) * 15 + row) * 256 + c4);
            else if ((tok0 & 16383) == 0) v = (f32x4){0.f, 0.f, 0.f, 0.f};
            else v = *(const f32x4*)(U + (size_t)(tok0 - 15 + row) * 256 + c4);
        } else v = *(const f32x4*)(U + (size_t)(tok0 + row - 15) * 256 + c4);
        *(f32x4*)(E + row * 256 + c4) = v;
    }
    __syncthreads();
    {
        const int c = tid & 255, th = tid >> 8, g = c >> 6, wdw = 2 << g, tin0 = tok0 & 16383;
#pragma unroll 1
        for (int tt = 0; tt < 16; ++tt) {
            const int t = th * 16 + tt; float s = 0.f;
#pragma unroll 2
            for (int i = 0; i < wdw; ++i) s += E[(15 + t - i) * 256 + c];
            const int cnt = smp ? wdw : min(wdw, tin0 + t + 1);
            const float pooled = s / (float)cnt - E[(15 + t) * 256 + c];
            PA[t * 264 + c] = bf1(pooled);
        }
    }
    __syncthreads();
    {
        const int g = w >> 1, nb = w & 1;
        const u16* pw = (const u16*)(ws + WS_PWT) + (size_t)(g * 64 + nb * 32 + r) * 64 + hh * 8;
        f32x16 acc;
#pragma unroll
        for (int i = 0; i < 16; ++i) acc[i] = 0.f;
#pragma unroll
        for (int ks = 0; ks < 4; ++ks) {
            const bf16x8 a = *(const bf16x8*)(PA + r * 264 + g * 64 + ks * 16 + hh * 8);
            const bf16x8 b = *(const bf16x8*)(pw + ks * 16);
            acc = MFMA32(a, b, acc);
        }
        const int col = g * 64 + nb * 32 + r; const float pb = p.pool_b[col], ps = p.pool_scale[col];
        const float* G = (const float*)(ws + WS_GP); u16* mo = (u16*)(ws + WS_MIX);
#pragma unroll
        for (int i = 0; i < 16; ++i) {
            const int tok = tok0 + (i & 3) + 8 * (i >> 2) + 4 * hh;
            mo[(size_t)tok * 1024 + col] = bf1((acc[i] + pb) * ps * G[(size_t)tok * 256 + col]);
        }
    }
    __syncthreads();
}

DI void phase2(const Params& p, int tid) {
    unsigned char* ws = p.ws;
    const int lane = tid & 63;
    const float sa = wave_sum(p.lq1[lane] * p.lk1[lane]), sb = wave_sum(p.lq2[lane] * p.lk2[lane]);
    const float lam = __expf(sa) - __expf(sb) + 0.2f;
    const u16* KB = (const u16*)(ws + WS_KB); const u16* VT = (const u16*)(ws + WS_VT);
    for (int pi = blockIdx.x; pi < 768; pi += gridDim.x) {
        int bh, j;
        if (gridDim.x == 256) { const int xcd = blockIdx.x & 7, slot = blockIdx.x >> 3, rnd = pi >> 8; bh = rnd * 4 + (xcd & 3); j = slot + 32 * (xcd >> 2); }
        else { bh = pi >> 6; j = pi & 63; }
        const int b = bh / 6, h = bh % 6;
        for (int half = 0; half < 2; ++half) {
            const int qb = half == 0 ? 127 - j : j;
            attn_unit(p, tid, b * SEQ + qb * 128, h, KB + (size_t)b * SEQ * 768 + h * 128, VT + (size_t)bh * 128 * SEQ, SEQ, 2 * qb + 2, false, lam);
        }
    }
    unsigned* ctrl = (unsigned*)(ws + WS_CTRL);
    const u16* KS = (const u16*)(ws + WS_KBS); const u16* VS = (const u16*)(ws + WS_VTS);
    for (;;) {
        if (tid == 0) *(volatile int*)(smem + LDS_SLOT) = (int)atomicAdd(ctrl, 1u);
        __syncthreads();
        const int u = *(volatile int*)(smem + LDS_SLOT);
        __syncthreads();
        if (u >= 48 + 1032) break;
        if (u < 48) {
            const int b = u / 6, h = u % 6;
            attn_unit(p, tid, NP + b * 32, h, KS + (size_t)b * SKV * 768 + h * 128, VS + (size_t)u * 128 * SKV, SKV, 17, true, lam);
        } else pool_unit(p, tid, u - 48);
    }
}

struct EpiOutProj {
    static constexpr bool PERM = false, AFTER_DRAIN = false;
    const float* xp; const float* xs; float* y; float* st;
    __device__ __forceinline__ void operator()(const pg8::f32x4 (&acc)[2][2][4][2], const pg8::Unit& u, int wr, int wc, int fr_, int fq_) const {
        int fr = fr_, fq = fq_; LAUNDER(fr); LAUNDER(fq);
        const int r0 = u.pm * 256 + wr * 64 + fr, c0 = u.pn * 256 + wc * 32 + 4 * fq;
#pragma unroll
        for (int ai = 0; ai < 2; ++ai)
#pragma unroll
            for (int m = 0; m < 4; ++m) {
                const int R = r0 + ai * 128 + m * 16;
                const float* xr = R < NP ? xp + (size_t)R * 1024 : xs + (size_t)(R - NP) * 1024;
                float* yr = y + (size_t)R * 1024;
                float s1 = 0.f, s2 = 0.f;
#pragma unroll
                for (int bj = 0; bj < 2; ++bj)
#pragma unroll
                    for (int n = 0; n < 2; ++n) {
                        const int C = c0 + bj * 128 + n * 16;
                        const f32x4 xv = *(const f32x4*)(xr + C);
                        const f32x4 z = xv * DN_ALPHA + acc[ai][bj][m][n];
                        *(f32x4*)(yr + C) = z;
                        s1 += (z.x + z.y) + (z.z + z.w); s2 += (z.x * z.x + z.y * z.y) + (z.z * z.z + z.w * z.w);
                    }
                s1 += __shfl_xor(s1, 16); s2 += __shfl_xor(s2, 16); s1 += __shfl_xor(s1, 32); s2 += __shfl_xor(s2, 32);
                if (fq == 0) { f32x2 pr; pr.x = s1; pr.y = s2; *(f32x2*)(st + ((size_t)R * 16 + u.pn * 4 + wc) * 2) = pr; }
                asm volatile("" ::: "memory");
            }
    }
};

DI void phase3a(const Params& p) {
    pg8::Gemm g{(const pg8::bf16_t*)(p.ws + WS_MIX), (const pg8::bf16_t*)(p.ws + WS_WTOUT), NT, 1024, 1024};
    pg8::StaticOrder S; S.init(NT, 1024, (int)gridDim.x, (int)blockIdx.x);
    EpiOutProj E{p.x_prompt, p.x_sample, p.out + O_YP, (float*)(p.ws + WS_ST)};
    pg8::gemm_phase<EpiOutProj, pg8::StaticOrder, true, true>((PG8_LAS unsigned char*)smem, g, S, E);
}

DI void phase3b(const Params& p, int tid) {
    const int lane = tid & 63, gw = blockIdx.x * 8 + (tid >> 6), nw = gridDim.x * 8;
    const float* st = (const float*)(p.ws + WS_ST);
    float* y = p.out + O_YP;
    f32x4 g[4], bb[4];
#pragma unroll
    for (int j = 0; j < 4; ++j) { g[j] = *(const f32x4*)(p.ln_g + j * 256 + lane * 4); bb[j] = *(const f32x4*)(p.ln_b + j * 256 + lane * 4); }
    for (int R0 = gw; R0 < NT; R0 += 2 * nw) {
        f32x4 z[2][4]; f32x2 pr[2];
#pragma unroll
        for (int k = 0; k < 2; ++k) {
            const int R = R0 + k * nw;
            if (R < NT) {
                pr[k] = *(const f32x2*)(st + ((size_t)R * 16 + (lane & 15)) * 2);
#pragma unroll
                for (int j = 0; j < 4; ++j) z[k][j] = *(const f32x4*)(y + (size_t)R * 1024 + j * 256 + lane * 4);
            }
        }
#pragma unroll
        for (int k = 0; k < 2; ++k) {
            const int R = R0 + k * nw;
            if (R < NT) {
                float s1 = pr[k].x, s2 = pr[k].y;
#pragma unroll
                for (int o = 8; o > 0; o >>= 1) { s1 += __shfl_xor(s1, o); s2 += __shfl_xor(s2, o); }
                const float mu = s1 * (1.0f / 1024.0f);
                const float var = fmaxf(s2 * (1.0f / 1024.0f) - mu * mu, 0.f);
                const float rstd = rsqrtf(var + 1e-5f);
#pragma unroll
                for (int j = 0; j < 4; ++j) *(f32x4*)(y + (size_t)R * 1024 + j * 256 + lane * 4) = (z[k][j] - mu) * rstd * g[j] + bb[j];
            }
        }
    }
}

__global__ void __launch_bounds__(512) fwd_kernel(Params p) {
    cg::grid_group grid = cg::this_grid();
    const int tid = threadIdx.x;
    phase0(p, tid);
    if (p.ws == nullptr) grid.sync();
    grid_barrier((unsigned*)(p.ws + WS_CTRL) + 192);
    phase1(p, tid);
    grid_barrier((unsigned*)(p.ws + WS_CTRL) + 64);
    phase2(p, tid);
    grid_barrier((unsigned*)(p.ws + WS_CTRL) + 128);
    phase3a(p);
    grid_barrier((unsigned*)(p.ws + WS_CTRL) + 256);
    phase3b(p, tid);
}

extern "C" void kernel_launch(void* const* d_in, const int* in_sizes, int n_in, void* d_out, int out_size, void* d_ws, size_t ws_size, hipStream_t stream) {
    static int grid = 0;
    if (grid == 0) {
        if (n_in != 17 || ws_size < WS_END) { fprintf(stderr, "kernel_launch: unexpected n_in %d / ws_size %zu (need %zu)\n", n_in, ws_size, (size_t)WS_END); grid = -1; return; }
        int dev = 0, cus = 0, per_cu = 0;
        hipGetDevice(&dev);
        hipDeviceGetAttribute(&cus, hipDeviceAttributeMultiprocessorCount, dev);
        if (hipFuncSetAttribute((const void*)fwd_kernel, hipFuncAttributeMaxDynamicSharedMemorySize, LDS_BYTES) != hipSuccess) { fprintf(stderr, "kernel_launch: hipFuncSetAttribute failed\n"); grid = -1; return; }
        if (hipOccupancyMaxActiveBlocksPerMultiprocessor(&per_cu, (const void*)fwd_kernel, 512, LDS_BYTES) != hipSuccess || per_cu < 1) { fprintf(stderr, "kernel_launch: occupancy query gave %d\n", per_cu); per_cu = 1; }
        (void)hipGetLastError();
        grid = cus * per_cu;
        fprintf(stderr, "kernel_launch: grid %d (cus %d x %d)\n", grid, cus, per_cu);
    }
    if (grid < 0) return;
    Params p{};
    p.x_prompt = (const float*)d_in[0]; p.x_sample = (const float*)d_in[1]; p.cache_k = (const float*)d_in[2]; p.cache_v = (const float*)d_in[3]; p.state_pool = (const float*)d_in[4];
    p.w_in = (const float*)d_in[5]; p.pool_w = (const float*)d_in[6]; p.pool_b = (const float*)d_in[7]; p.pool_scale = (const float*)d_in[8];
    p.lq1 = (const float*)d_in[9]; p.lk1 = (const float*)d_in[10]; p.lq2 = (const float*)d_in[11]; p.lk2 = (const float*)d_in[12]; p.subln_g = (const float*)d_in[13];
    p.w_out = (const float*)d_in[14]; p.ln_g = (const float*)d_in[15]; p.ln_b = (const float*)d_in[16];
    p.out = (float*)d_out; p.ws = (unsigned char*)d_ws;
    if (hipMemsetAsync((char*)d_ws + WS_CTRL, 0, 4096, stream) != hipSuccess) { fprintf(stderr, "kernel_launch: hipMemsetAsync failed\n"); return; }
    void* args[] = {&p};
    hipError_t e = hipLaunchCooperativeKernel((const void*)fwd_kernel, dim3(grid), dim3(512), args, LDS_BYTES, stream);
    if (e != hipSuccess) fprintf(stderr, "kernel_launch: cooperative launch failed: %s (grid %d)\n", hipGetErrorString(e), grid);
}
```

```cpp
#include <hip/hip_runtime.h>
#include <hip/hip_cooperative_groups.h>
#include <cstdio>
#include <cstdint>
namespace cg = cooperative_groups;

typedef short bf16x8 __attribute__((ext_vector_type(8)));
typedef float f32x16 __attribute__((ext_vector_type(16)));
typedef float f32x4 __attribute__((ext_vector_type(4)));
typedef float f32x2 __attribute__((ext_vector_type(2)));
typedef __bf16 bf16x2_t __attribute__((ext_vector_type(2)));
typedef unsigned u32x4 __attribute__((ext_vector_type(4)));
typedef unsigned u32x2 __attribute__((ext_vector_type(2)));
typedef unsigned short u16;

#define MFMA32(a, b, c) __builtin_amdgcn_mfma_f32_32x32x16_bf16((a), (b), (c), 0, 0, 0)
#define DI __device__ __forceinline__

constexpr int NP = 32768, NS = 256, NT = NP + NS;
constexpr int INW = 3584, SEQ = 16384, SKV = 1088;
constexpr int LDS_BYTES = 147456;
constexpr int LDS_SLOT = 147440;
constexpr int XOFF = 73728;

constexpr size_t WS_CTRL = 0;
constexpr size_t WS_XB = 4096;
constexpr size_t WS_WTIN = WS_XB + (size_t)NT * 1024 * 2;
constexpr size_t WS_WTOUT = WS_WTIN + (size_t)INW * 1024 * 2;
constexpr size_t WS_PWT = WS_WTOUT + (size_t)1024 * 1024 * 2;
constexpr size_t WS_U = WS_PWT + 32768;
constexpr size_t WS_GP = WS_U + (size_t)NT * 256 * 4;
constexpr size_t WS_QB = WS_GP + (size_t)NT * 256 * 4;
constexpr size_t WS_KB = WS_QB + (size_t)NT * 768 * 2;
constexpr size_t WS_KBS = WS_KB + (size_t)NP * 768 * 2;
constexpr size_t WS_VT = WS_KBS + (size_t)8 * SKV * 768 * 2;
constexpr size_t WS_VTS = WS_VT + (size_t)12 * 128 * SEQ * 2;
constexpr size_t WS_GA = WS_VTS + (size_t)48 * 128 * SKV * 2;
constexpr size_t WS_MIX = WS_GA + (size_t)NT * 768 * 2;
constexpr size_t WS_ST = WS_MIX + (size_t)NT * 1024 * 2;
constexpr size_t WS_END = WS_ST + (size_t)NT * 16 * 8;

constexpr size_t O_YP = 0, O_KP = 33816576, O_VP = 58982400, O_PP = 84148224, O_KS = 84155904, O_VS = 84352512, O_PS = 84549120;

constexpr float QSCALE = 0.125f * 1.4426950408889634f;
constexpr float DN_ALPHA = 1.189207115002721f;

struct Params {
    const float* x_prompt; const float* x_sample; const float* cache_k; const float* cache_v; const float* state_pool;
    const float* w_in; const float* pool_w; const float* pool_b; const float* pool_scale;
    const float* lq1; const float* lk1; const float* lq2; const float* lk2; const float* subln_g;
    const float* w_out; const float* ln_g; const float* ln_b;
    float* out; unsigned char* ws;
};

extern __shared__ __attribute__((aligned(16))) unsigned char smem[];

DI unsigned pk(float lo, float hi) { f32x2 v = {lo, hi}; bf16x2_t b = __builtin_convertvector(v, bf16x2_t); return __builtin_bit_cast(unsigned, b); }
DI u16 bf1(float x) { __bf16 b = (__bf16)x; return __builtin_bit_cast(u16, b); }
DI float bf_lo(unsigned w) { return __uint_as_float(w << 16); }
DI float bf_hi(unsigned w) { return __uint_as_float(w & 0xffff0000u); }
DI float silu(float v) { return v / (1.0f + __expf(-v)); }
DI float wave_sum(float v) {
#pragma unroll
    for (int o = 32; o > 0; o >>= 1) v += __shfl_xor(v, o);
    return v;
}
typedef __amdgpu_buffer_rsrc_t rsrc_t;
DI rsrc_t mkrsrc(const void* p) { return __builtin_amdgcn_make_buffer_rsrc((void*)p, 0, 0x7fffffff, 0x00020000); }
DI u32x4 bload(rsrc_t rs, unsigned voff, unsigned soff) { return __builtin_amdgcn_raw_buffer_load_b128(rs, voff, soff, 0); }
#define LAUNDER(x) asm volatile("" : "+v"(x))
DI int perm16(int s) { return (s & ~12) | ((s & 4) << 1) | ((s & 8) >> 1); }

DI void grid_barrier(unsigned* cnt) {
    __syncthreads();
    if (threadIdx.x == 0) {
        __builtin_amdgcn_fence(__ATOMIC_RELEASE, "agent");
        __hip_atomic_fetch_add(cnt, 1u, __ATOMIC_RELAXED, __HIP_MEMORY_SCOPE_AGENT);
        const unsigned want = gridDim.x;
        while (__hip_atomic_load(cnt, __ATOMIC_RELAXED, __HIP_MEMORY_SCOPE_AGENT) < want) __builtin_amdgcn_s_sleep(2);
        __builtin_amdgcn_fence(__ATOMIC_ACQUIRE, "agent");
    }
    __syncthreads();
}
DI void phase0(const Params& p, int tid) {
    unsigned char* ws = p.ws;
    const int wv = tid >> 6;
    if (wv < 4) {
        const size_t g0 = (size_t)blockIdx.x * 256 + tid, gs = (size_t)gridDim.x * 256;
        u16* xb = (u16*)(ws + WS_XB);
        const size_t N = (size_t)NT * 128;
        for (size_t i0 = g0; i0 < N; i0 += 4 * gs) {
            f32x4 a[4], b[4];
#pragma unroll
            for (int u = 0; u < 4; ++u) {
                const size_t i = i0 + u * gs;
                if (i < N) {
                    const size_t e = i * 8;
                    const float* s = e < (size_t)NP * 1024 ? p.x_prompt + e : p.x_sample + (e - (size_t)NP * 1024);
                    a[u] = *(const f32x4*)s; b[u] = *(const f32x4*)(s + 4);
                }
            }
#pragma unroll
            for (int u = 0; u < 4; ++u) {
                const size_t i = i0 + u * gs;
                if (i < N) {
                    u32x4 w; w.x = pk(a[u].x, a[u].y); w.y = pk(a[u].z, a[u].w); w.z = pk(b[u].x, b[u].y); w.w = pk(b[u].z, b[u].w);
                    *(u32x4*)(xb + i * 8) = w;
                }
            }
        }
    } else if (wv < 6) {
        const size_t g0 = (size_t)blockIdx.x * 128 + (tid - 256), gs = (size_t)gridDim.x * 128;
        {
            u16* wt = (u16*)(ws + WS_WTIN);
            for (size_t i = g0; i < (size_t)INW * 128; i += gs) {
                const int n = (int)(i % INW), k8 = (int)(i / INW);
                const float* s = p.w_in + (size_t)k8 * 8 * INW + n;
                float v[8];
#pragma unroll
                for (int j = 0; j < 8; ++j) v[j] = s[(size_t)j * INW];
                u32x4 w; w.x = pk(v[0], v[1]); w.y = pk(v[2], v[3]); w.z = pk(v[4], v[5]); w.w = pk(v[6], v[7]);
                *(u32x4*)(wt + (size_t)n * 1024 + k8 * 8) = w;
            }
        }
        {
            u16* wt = (u16*)(ws + WS_WTOUT);
            for (size_t i = g0; i < (size_t)1024 * 128; i += gs) {
                const int n = (int)(i & 1023), k8 = (int)(i >> 10);
                const float* s = p.w_out + (size_t)k8 * 8 * 1024 + n;
                float v[8];
#pragma unroll
                for (int j = 0; j < 8; ++j) v[j] = s[(size_t)j * 1024];
                u32x4 w; w.x = pk(v[0], v[1]); w.y = pk(v[2], v[3]); w.z = pk(v[4], v[5]); w.w = pk(v[6], v[7]);
                *(u32x4*)(wt + (size_t)n * 1024 + k8 * 8) = w;
            }
        }
        {
            u16* pw = (u16*)(ws + WS_PWT);
            for (size_t i = g0; i < 16384; i += gs) {
                const int g = (int)(i >> 12), d = (int)((i >> 6) & 63), c = (int)(i & 63);
                pw[i] = bf1(p.pool_w[g * 4096 + c * 64 + d]);
            }
        }
    } else {
        const size_t g0 = (size_t)blockIdx.x * 128 + (tid - 384), gs = (size_t)gridDim.x * 128;
        {
            u16* kb = (u16*)(ws + WS_KBS);
            const size_t NK = (size_t)8 * 1024 * 96;
            for (size_t i0 = g0; i0 < NK; i0 += 4 * gs) {
                f32x4 a[4], c[4];
#pragma unroll
                for (int u = 0; u < 4; ++u) { const size_t i = i0 + u * gs; if (i < NK) { const float* s = p.cache_k + i * 8; a[u] = *(const f32x4*)s; c[u] = *(const f32x4*)(s + 4); } }
#pragma unroll
                for (int u = 0; u < 4; ++u) {
                    const size_t i = i0 + u * gs;
                    if (i < NK) {
                        const size_t e = i * 8; const int b = (int)(e / (1024 * 768)); const int rem = (int)(e % (1024 * 768));
                        u32x4 w; w.x = pk(a[u].x, a[u].y); w.y = pk(a[u].z, a[u].w); w.z = pk(c[u].x, c[u].y); w.w = pk(c[u].z, c[u].w);
                        *(u32x4*)(kb + (size_t)b * SKV * 768 + rem) = w;
                    }
                }
            }
            for (size_t i = g0; i < (size_t)8 * 32 * 96; i += gs) {
                const int e = (int)i * 8; const int b = e / (32 * 768), rem = e % (32 * 768);
                u32x4 z = {0u, 0u, 0u, 0u};
                *(u32x4*)(kb + ((size_t)b * SKV + 1056) * 768 + rem) = z;
            }
        }
        {
            u16* vt = (u16*)(ws + WS_VTS);
            for (size_t i = g0; i < (size_t)48 * 64 * 128; i += gs) {
                const int d = (int)(i & 127), s16 = (int)((i >> 7) & 63), bh = (int)(i >> 13), b = bh / 6, h = bh % 6;
                const float* s = p.cache_v + ((size_t)(b * 1024 + s16 * 16) * 6 + h) * 128 + d;
                float v[16];
#pragma unroll
                for (int j = 0; j < 16; ++j) v[j] = s[(size_t)j * 768];
                u32x4 w0, w1;
                w0.x = pk(v[0], v[1]); w0.y = pk(v[2], v[3]); w0.z = pk(v[8], v[9]); w0.w = pk(v[10], v[11]);
                w1.x = pk(v[4], v[5]); w1.y = pk(v[6], v[7]); w1.z = pk(v[12], v[13]); w1.w = pk(v[14], v[15]);
                u16* dst = vt + ((size_t)bh * 128 + d) * SKV + s16 * 16;
                *(u32x4*)dst = w0; *(u32x4*)(dst + 8) = w1;
            }
            for (size_t i = g0; i < (size_t)48 * 128 * 4; i += gs) {
                u32x4 z = {0u, 0u, 0u, 0u};
                *(u32x4*)(vt + (i >> 2) * SKV + 1056 + (i & 3) * 8) = z;
            }
        }
    }
}

template <int MB, int NB, bool FENCE = false>
DI void mma_ktile(int aoff, int boff, int r, int hh, f32x16 (&acc)[MB][NB]) {
    const int sw = (r >> 1) & 7;
#pragma unroll
    for (int ks = 0; ks < 4; ++ks) {
        if (FENCE && (ks > 0)) __builtin_amdgcn_sched_barrier(0);
        const int co = ((2 * ks + hh) ^ sw) << 4;
        bf16x8 a[MB], b[NB];
#pragma unroll
        for (int mb = 0; mb < MB; ++mb) a[mb] = *(const bf16x8*)(smem + aoff + (mb * 32 + r) * 128 + co);
#pragma unroll
        for (int nb = 0; nb < NB; ++nb) b[nb] = *(const bf16x8*)(smem + boff + (nb * 32 + r) * 128 + co);
#pragma unroll
        for (int mb = 0; mb < MB; ++mb)
#pragma unroll
            for (int nb = 0; nb < NB; ++nb) acc[mb][nb] = MFMA32(a[mb], b[nb], acc[mb][nb]);
    }
}

namespace pg8 {
#define PG8_LAS __attribute__((address_space(3)))
typedef unsigned short bf16_t;
typedef short bf16x8 __attribute__((ext_vector_type(8)));
typedef float f32x4 __attribute__((ext_vector_type(4)));
typedef unsigned u32x4 __attribute__((ext_vector_type(4)));
constexpr int BM = 256, BK = 64, HALF = 128, HTB = HALF * BK * 2  , STAGE_BYTES = 8 * HTB, NXCD = 8, WGM = 8;

__host__ __device__ __forceinline__ int lds_byte(int r, int c) { const int st = (r >> 4) * 2 + (c >> 5), rr = r & 15, cc = c & 31, ob = rr * 64 + cc * 2; return st * 1024 + (ob ^ (((ob >> 9) & 1) << 5)); }
__host__ __device__ __forceinline__ void stage_rc(int b, int& R, int& C) { const int st = b / 1024, sb = b % 1024, swz = sb ^ (((sb >> 9) & 1) << 5); R = (st >> 1) * 16 + swz / 64; C = (st & 1) * 32 + (swz % 64) / 2; }
__host__ __device__ __forceinline__ int perm32(int rho) { const int n = rho >> 4, i = rho & 15; return 8 * (i >> 2) + 4 * n + (i & 3); }

struct Unit { int pm, pn; };
struct Gemm { const bf16_t* A; const bf16_t* Bt; int M, N, K; };

struct StaticOrder {
    int nM, nN, nwg, G, c;
    __host__ __device__ void init(int M, int N, int G_, int c_) { nM = M / BM; nN = N / BM; nwg = nM * nN; G = G_; c = c_; }
    __host__ __device__ bool next(int i, Unit& u) const {
        const long L = (long)i * G + c; if (L >= nwg) return false;
        int wgid = (int)L; { const int q = nwg / NXCD, r = nwg % NXCD, xcd = wgid % NXCD, off = wgid / NXCD; wgid = (xcd < r ? xcd * (q + 1) : r * (q + 1) + (xcd - r) * q) + off; }
        const int nig = WGM * nN, gid = wgid / nig, fm = gid * WGM, gsz = (nM - fm) < WGM ? (nM - fm) : WGM;
        u.pm = fm + ((wgid % nig) % gsz); u.pn = (wgid % nig) / gsz; return true;
    }
    __device__ __forceinline__ void a_ready(const Unit&) const {}
    __device__ __forceinline__ void done(const Unit&) const {}
};

typedef float f32x2 __attribute__((ext_vector_type(2)));
template <class Epi, class Sched, bool ALIGN_EPI = false, bool SP2 = false>
__device__ __forceinline__ void gemm_phase(PG8_LAS unsigned char* lds, const Gemm g, const Sched& S, const Epi& E) {
    const int tid = threadIdx.x, wid = __builtin_amdgcn_readfirstlane(tid >> 6), lane = tid & 63, wr = wid >> 2, wc = wid & 3, fr = lane & 15, fq = lane >> 4;
    const int K = g.K, nt = K / BK;
    unsigned voffA[2], voffB[2];
#pragma unroll
    for (int i = 0; i < 2; ++i) { int R, C; stage_rc(tid * 16 + i * 8192, R, C); const int Rb = Epi::PERM ? ((R & ~31) + perm32(R & 31)) : R;
        voffA[i] = (unsigned)(R * K + C) * 2u; voffB[i] = (unsigned)(Rb * K + C) * 2u; }
    const size_t kstep = (size_t)(BK * 2);
    const size_t hstep = (size_t)HALF * K * 2;
    const size_t tstep = 2 * hstep;
    const unsigned ldsw = (unsigned)wid * 1024u;
    const int aoff = lds_byte(wr * 64 + fr, fq * 8), boff = lds_byte(wc * 32 + fr, fq * 8);
#define PG8_SA(b, h) (((b) * 2 + (h)) * HTB)
#define PG8_SB(b, h) ((4 + (b) * 2 + (h)) * HTB)
#define PG8_STAGE(bufoff, gbase, voff) do { _Pragma("unroll") for (int _i = 0; _i < 2; ++_i) \
        __builtin_amdgcn_global_load_lds((const unsigned*)((const char*)(gbase) + (voff)[_i]), (PG8_LAS unsigned*)(lds + (bufoff) + ldsw + _i * 8192), 16, 0, 0); } while (0)
#define PG8_LDA(dst, b, h) do { _Pragma("unroll") for (int m = 0; m < 4; ++m) _Pragma("unroll") for (int k = 0; k < 2; ++k) dst[m][k] = *(const PG8_LAS bf16x8*)(lds + PG8_SA(b, h) + aoff + m * 2048 + k * 1024); } while (0)
#define PG8_LDB(dst, b, h) do { _Pragma("unroll") for (int n = 0; n < 2; ++n) _Pragma("unroll") for (int k = 0; k < 2; ++k) dst[n][k] = *(const PG8_LAS bf16x8*)(lds + PG8_SB(b, h) + boff + n * 2048 + k * 1024); } while (0)
#define PG8_MMA(ai, bj, At, Bt) do { __builtin_amdgcn_s_setprio(1); _Pragma("unroll") for (int m = 0; m < 4; ++m) _Pragma("unroll") for (int n = 0; n < 2; ++n) _Pragma("unroll") for (int k = 0; k < 2; ++k) \
        acc[ai][bj][m][n] = __builtin_amdgcn_mfma_f32_16x16x32_bf16(Bt[n][k], At[m][k], acc[ai][bj][m][n], 0, 0, 0); __builtin_amdgcn_s_setprio(0); } while (0)
#define PG8_WAIT_V(n) asm volatile("s_waitcnt vmcnt(" #n ")" ::: "memory")
#define PG8_WAIT_L(n) asm volatile("s_waitcnt lgkmcnt(" #n ")" ::: "memory")
#define PG8_BAR __builtin_amdgcn_s_barrier()
#define PG8_SCHED __builtin_amdgcn_sched_barrier(0)
    Unit cur, nxt; int ui = 0;
    if (!S.next(0, cur)) return;
    f32x4 acc[2][2][4][2];
#pragma unroll
    for (int a = 0; a < 2; ++a)
#pragma unroll
        for (int b = 0; b < 2; ++b)
#pragma unroll
            for (int m = 0; m < 4; ++m)
#pragma unroll
                for (int n = 0; n < 2; ++n) acc[a][b][m][n] = (f32x4){0.f, 0.f, 0.f, 0.f};
    bf16x8 At[4][2], B0[2][2], B1[2][2];
    const char* cA = (const char*)g.A + (size_t)cur.pm * tstep; const char* cB = (const char*)g.Bt + (size_t)cur.pn * tstep;
    S.a_ready(cur);
    if constexpr (SP2) {
        PG8_STAGE(PG8_SB(0, 0), cB, voffB); PG8_STAGE(PG8_SB(0, 1), cB + hstep, voffB); PG8_STAGE(PG8_SA(0, 0), cA, voffA); PG8_STAGE(PG8_SA(0, 1), cA + hstep, voffA);
        if (wr == 1) PG8_BAR;
        PG8_WAIT_V(2); PG8_BAR;
        PG8_STAGE(PG8_SB(1, 0), cB + kstep, voffB); PG8_STAGE(PG8_SA(1, 0), cA + kstep, voffA); PG8_STAGE(PG8_SB(1, 1), cB + hstep + kstep, voffB);
        PG8_WAIT_V(6); PG8_BAR;
    } else {
        PG8_STAGE(PG8_SB(0, 0), cB, voffB); PG8_STAGE(PG8_SA(0, 0), cA, voffA); PG8_STAGE(PG8_SB(0, 1), cB + hstep, voffB); PG8_STAGE(PG8_SA(0, 1), cA + hstep, voffA);
        if (wr == 1) PG8_BAR;
        PG8_WAIT_V(4); PG8_BAR;
        PG8_STAGE(PG8_SB(1, 0), cB + kstep, voffB); PG8_STAGE(PG8_SA(1, 0), cA + kstep, voffA); PG8_STAGE(PG8_SB(1, 1), cB + hstep + kstep, voffB);
        PG8_WAIT_V(6); PG8_BAR;
    }
    for (;;) {
        const bool has_next = S.next(ui + 1, nxt);
        const char* nA = has_next ? (const char*)g.A + (size_t)nxt.pm * tstep : cA; const char* nB = has_next ? (const char*)g.Bt + (size_t)nxt.pn * tstep : cB;
        for (int t = 0; t < nt; t += 2) {
            const bool last = (t == nt - 2);
            const char* a1 = cA + (size_t)(t + 1) * kstep;
            const char* a2 = last ? nA : cA + (size_t)(t + 2) * kstep; const char* b2 = last ? nB : cB + (size_t)(t + 2) * kstep;
            const char* a3 = a2 + kstep; const char* b3 = b2 + kstep;
            if (last && has_next) S.a_ready(nxt);
            if constexpr (SP2) {
            PG8_LDB(B0, 0, 0); PG8_LDB(B1, 0, 1); PG8_SCHED; PG8_LDA(At, 0, 0); PG8_STAGE(PG8_SA(1, 1), a1 + hstep, voffA);
            PG8_WAIT_V(8); PG8_WAIT_L(0); PG8_BAR; PG8_MMA(0, 0, At, B0); PG8_MMA(0, 1, At, B1); PG8_BAR; PG8_SCHED;
            PG8_LDA(At, 0, 1); PG8_STAGE(PG8_SB(0, 0), b2, voffB); PG8_STAGE(PG8_SB(0, 1), b2 + hstep, voffB); PG8_STAGE(PG8_SA(0, 0), a2, voffA);
            PG8_WAIT_V(8); PG8_WAIT_L(0); PG8_BAR; PG8_MMA(1, 0, At, B0); PG8_MMA(1, 1, At, B1); PG8_BAR; PG8_SCHED;
            PG8_LDB(B0, 1, 0); PG8_LDB(B1, 1, 1); PG8_SCHED; PG8_LDA(At, 1, 0); PG8_STAGE(PG8_SA(0, 1), a2 + hstep, voffA);
            PG8_WAIT_V(8); PG8_WAIT_L(0); PG8_BAR; PG8_MMA(0, 0, At, B0); PG8_MMA(0, 1, At, B1); PG8_BAR; PG8_SCHED;
            PG8_LDA(At, 1, 1); PG8_STAGE(PG8_SB(1, 0), b3, voffB); PG8_STAGE(PG8_SB(1, 1), b3 + hstep, voffB); PG8_STAGE(PG8_SA(1, 0), a3, voffA);
            PG8_WAIT_V(8); PG8_WAIT_L(0); PG8_BAR; PG8_MMA(1, 0, At, B0); PG8_MMA(1, 1, At, B1); PG8_BAR; PG8_SCHED;
            } else {
            PG8_LDB(B0, 0, 0); PG8_SCHED; PG8_LDA(At, 0, 0); PG8_STAGE(PG8_SA(1, 1), a1 + hstep, voffA);
            PG8_WAIT_L(8); PG8_BAR; PG8_WAIT_L(0); PG8_MMA(0, 0, At, B0); PG8_BAR; PG8_SCHED;
            PG8_LDB(B1, 0, 1); PG8_STAGE(PG8_SB(0, 0), b2, voffB);
            PG8_BAR; PG8_WAIT_L(0); PG8_MMA(0, 1, At, B1); PG8_BAR;
            PG8_LDA(At, 0, 1); PG8_STAGE(PG8_SA(0, 0), a2, voffA);
            PG8_BAR; PG8_WAIT_L(0); PG8_MMA(1, 0, At, B0); PG8_BAR; PG8_SCHED;
            PG8_STAGE(PG8_SB(0, 1), b2 + hstep, voffB);
            PG8_WAIT_V(6); PG8_BAR; PG8_MMA(1, 1, At, B1); PG8_BAR;
            PG8_LDB(B0, 1, 0); PG8_SCHED; PG8_LDA(At, 1, 0); PG8_STAGE(PG8_SA(0, 1), a2 + hstep, voffA);
            PG8_WAIT_L(8); PG8_BAR; PG8_WAIT_L(0); PG8_MMA(0, 0, At, B0); PG8_BAR; PG8_SCHED;
            PG8_LDB(B1, 1, 1); PG8_STAGE(PG8_SB(1, 0), b3, voffB);
            PG8_BAR; PG8_WAIT_L(0); PG8_MMA(0, 1, At, B1); PG8_BAR;
            PG8_LDA(At, 1, 1); PG8_STAGE(PG8_SA(1, 0), a3, voffA);
            PG8_BAR; PG8_WAIT_L(0); PG8_MMA(1, 0, At, B0); PG8_BAR; PG8_SCHED;
            PG8_STAGE(PG8_SB(1, 1), b3 + hstep, voffB);
            PG8_WAIT_V(6); PG8_BAR; PG8_MMA(1, 1, At, B1); PG8_BAR;
            }
        }
        if constexpr (ALIGN_EPI) { if (wr == 0) PG8_BAR; }
        if constexpr (!Epi::AFTER_DRAIN) { E(acc, cur, wr, wc, fr, fq); S.done(cur); }
        if (!has_next) break;
#pragma unroll
        for (int a = 0; a < 2; ++a)
#pragma unroll
            for (int b = 0; b < 2; ++b)
#pragma unroll
                for (int m = 0; m < 4; ++m)
#pragma unroll
                    for (int n = 0; n < 2; ++n) acc[a][b][m][n] = (f32x4){0.f, 0.f, 0.f, 0.f};
        cur = nxt; cA = nA; cB = nB; ++ui;
        if constexpr (ALIGN_EPI) { if (wr == 1) PG8_BAR; }
    }
    PG8_WAIT_V(0);
    if constexpr (!ALIGN_EPI) { if (wr == 0) PG8_BAR; }
    PG8_BAR;
    if constexpr (Epi::AFTER_DRAIN) { E.fused(acc, cur, wr, wc, fr, fq, lds, wid, lane); S.done(cur); }
#undef PG8_SA
#undef PG8_SB
#undef PG8_STAGE
#undef PG8_LDA
#undef PG8_LDB
#undef PG8_MMA
#undef PG8_WAIT_V
#undef PG8_WAIT_L
#undef PG8_BAR
#undef PG8_SCHED
}
}

struct EpiInProj {
    static constexpr bool PERM = false, AFTER_DRAIN = false;
    unsigned char* ws; float* out;
    __device__ __forceinline__ void operator()(const pg8::f32x4 (&acc)[2][2][4][2], const pg8::Unit& u, int wr, int wc, int fr_, int fq_) const {
        int fr = fr_, fq = fq_; LAUNDER(fr); LAUNDER(fq);
        const int pm = u.pm, pn = u.pn; const bool smp = (pm == 128);
        const int r0 = pm * 256 + wr * 64 + fr, c0 = wc * 32 + 4 * fq;
#pragma unroll
        for (int ai = 0; ai < 2; ++ai)
#pragma unroll
            for (int m = 0; m < 4; ++m) {
                const int R = r0 + ai * 128 + m * 16;
#pragma unroll
                for (int bj = 0; bj < 2; ++bj)
#pragma unroll
                    for (int n = 0; n < 2; ++n) {
                        const int ct = c0 + bj * 128 + n * 16;
                        const f32x4 v = acc[ai][bj][m][n];
                        if (pn == 0) {
                            *(f32x4*)((float*)(ws + WS_U) + (size_t)R * 256 + ct) = v;
                            if (!smp) { const int t = R & 16383; if (t >= 16369) *(f32x4*)(out + O_PP + (size_t)((R >> 14) * 15 + (t - 16369)) * 256 + ct) = v; }
                            else { const int rs = R - NP, t = rs & 31; if (t >= 17) *(f32x4*)(out + O_PS + (size_t)((rs >> 5) * 15 + (t - 17)) * 256 + ct) = v; }
                        } else if (pn == 1) {
                            f32x4 g; g.x = silu(v.x); g.y = silu(v.y); g.z = silu(v.z); g.w = silu(v.w);
                            *(f32x4*)((float*)(ws + WS_GP) + (size_t)R * 256 + ct) = g;
                        } else if (pn < 5) {
                            u32x2 q; q.x = pk(v.x * QSCALE, v.y * QSCALE); q.y = pk(v.z * QSCALE, v.w * QSCALE);
                            *(u32x2*)((u16*)(ws + WS_QB) + (size_t)R * 768 + (pn - 2) * 256 + ct) = q;
                        } else if (pn < 8) {
                            const int cc = (pn - 5) * 256 + ct;
                            u32x2 q; q.x = pk(v.x, v.y); q.y = pk(v.z, v.w);
                            if (!smp) { *(f32x4*)(out + O_KP + (size_t)R * 768 + cc) = v; *(u32x2*)((u16*)(ws + WS_KB) + (size_t)R * 768 + cc) = q; }
                            else { const int rs = R - NP; *(f32x4*)(out + O_KS + (size_t)rs * 768 + cc) = v; *(u32x2*)((u16*)(ws + WS_KBS) + ((size_t)(rs >> 5) * SKV + 1024 + (rs & 31)) * 768 + cc) = q; }
                        } else if (pn < 11) {
                            const int cc = (pn - 8) * 256 + ct, h = cc >> 7, d = cc & 127;
                            if (!smp) {
                                *(f32x4*)(out + O_VP + (size_t)R * 768 + cc) = v;
                                const int b = R >> 14, sq = R & 16383;
                                u16* vt = (u16*)(ws + WS_VT) + ((size_t)(b * 6 + h) * 128 + d) * SEQ + perm16(sq);
                                vt[0] = bf1(v.x); vt[SEQ] = bf1(v.y); vt[2 * SEQ] = bf1(v.z); vt[3 * SEQ] = bf1(v.w);
                            } else {
                                const int rs = R - NP;
                                *(f32x4*)(out + O_VS + (size_t)rs * 768 + cc) = v;
                                u16* vt = (u16*)(ws + WS_VTS) + ((size_t)((rs >> 5) * 6 + h) * 128 + d) * SKV + 1024 + perm16(rs & 31);
                                vt[0] = bf1(v.x); vt[SKV] = bf1(v.y); vt[2 * SKV] = bf1(v.z); vt[3 * SKV] = bf1(v.w);
                            }
                        } else {
                            u32x2 q; q.x = pk(silu(v.x), silu(v.y)); q.y = pk(silu(v.z), silu(v.w));
                            *(u32x2*)((u16*)(ws + WS_GA) + (size_t)R * 768 + (pn - 11) * 256 + ct) = q;
                        }
                    }
                asm volatile("" ::: "memory");
            }
    }
};

DI void phase1(const Params& p, int tid) {
    (void)tid;
    pg8::Gemm g{(const pg8::bf16_t*)(p.ws + WS_XB), (const pg8::bf16_t*)(p.ws + WS_WTIN), NT, INW, 1024};
    pg8::StaticOrder S; S.init(NT, INW, (int)gridDim.x, (int)blockIdx.x);
    EpiInProj E{p.ws, p.out};
    pg8::gemm_phase<EpiInProj, pg8::StaticOrder, true, true>((PG8_LAS unsigned char*)smem, g, S, E);
}

DI void attn_unit(const Params& p, int tid, int qtok0, int h, const u16* kbase, const u16* vbase, int vstride, int ntiles, bool sample, float lam) {
    const int lane = tid & 63, w = tid >> 6, r = lane & 31, hh = lane >> 5, pair = w >> 1, cm = w & 1;
    unsigned char* ws = p.ws;
    int ntw = sample ? (pair == 0 ? ntiles : 0) : (ntiles - 1 + (pair >> 1));
    ntw = __builtin_amdgcn_readfirstlane(ntw);
    bf16x8 Qf[4];
    {
        const u16* qrow = (const u16*)(ws + WS_QB) + (size_t)(qtok0 + pair * 32 + r) * 768 + h * 128 + cm * 64 + hh * 8;
#pragma unroll
        for (int ks = 0; ks < 4; ++ks) {
            if (ntw > 0) Qf[ks] = *(const bf16x8*)(qrow + ks * 16);
            else Qf[ks] = (bf16x8){0, 0, 0, 0, 0, 0, 0, 0};
        }
    }
    f32x16 O[4];
#pragma unroll
    for (int d = 0; d < 4; ++d)
#pragma unroll
        for (int i = 0; i < 16; ++i) O[d][i] = 0.f;
    float m = 0.f, l = 0.f; bool shifted = false;

    const int krow = tid >> 4, kch = tid & 15;
    const int kdst = krow * 256 + ((kch ^ (krow & 15)) << 4);
    const rsrc_t kg = mkrsrc(kbase);
    const unsigned kvo = (unsigned)(krow * 1536 + kch * 16);
    const int vrow = tid >> 3, vch = tid & 7;
    const int vdst = 16384 + vrow * 128 + ((vch ^ ((vrow >> 1) & 7)) << 4);
    const rsrc_t vg = mkrsrc(vbase);
    const unsigned vvo = (unsigned)(vrow * vstride * 2 + vch * 16);
    const unsigned vstep = 128u * (unsigned)vstride;
    u32x4 rk[2], rv[2];
#pragma unroll
    for (int i = 0; i < 2; ++i) { rk[i] = bload(kg, kvo, i * 49152); rv[i] = bload(vg, vvo, i * vstep); }
#pragma unroll
    for (int i = 0; i < 2; ++i) { *(u32x4*)(smem + kdst + i * 8192) = rk[i]; *(u32x4*)(smem + vdst + i * 8192) = rv[i]; }
    __syncthreads();
    const int ksw = r & 15, vsw = (r >> 1) & 7;
    for (int t = 0; t < ntiles; ++t) {
        const int cur = (t & 1) * 32768, nxt = 32768 - cur;
        if (t + 1 < ntiles) {
#pragma unroll
            for (int i = 0; i < 2; ++i) { rk[i] = bload(kg, kvo, ((t + 1) * 64 + i * 32) * 1536); rv[i] = bload(vg, vvo, (t + 1) * 128 + i * vstep); }
        }
        if (t < ntw) {
            f32x16 S0, S1;
#pragma unroll
            for (int i = 0; i < 16; ++i) { S0[i] = 0.f; S1[i] = 0.f; }
            const int kro = cur + r * 256;
            const int vro = cur + 16384 + r * 128;
            bf16x8 kf[8];
#pragma unroll
            for (int ks = 0; ks < 4; ++ks) {
                const int co = ((cm * 8 + ks * 2 + hh) ^ ksw) << 4;
                kf[2 * ks] = *(const bf16x8*)(smem + kro + co);
                kf[2 * ks + 1] = *(const bf16x8*)(smem + kro + 8192 + co);
            }
            __builtin_amdgcn_sched_barrier(0);
            __builtin_amdgcn_s_setprio(1);
#pragma unroll
            for (int ks = 0; ks < 4; ++ks) { S0 = MFMA32(kf[2 * ks], Qf[ks], S0); S1 = MFMA32(kf[2 * ks + 1], Qf[ks], S1); }
            __builtin_amdgcn_s_setprio(0);
            bf16x8 vf[4];
            {
                const int co0 = (hh ^ vsw) << 4;
#pragma unroll
                for (int d = 0; d < 4; ++d) vf[d] = *(const bf16x8*)(smem + vro + d * 4096 + co0);
            }
            __builtin_amdgcn_sched_barrier(0);

            if (shifted) { S0 -= m; S1 -= m; }
            if (sample && t == ntiles - 1) {
#pragma unroll
                for (int i = 0; i < 16; ++i) S1[i] = -INFINITY;
            }
            float mxa = fmaxf(fmaxf(S0[0], S0[1]), S0[2]), mxb = fmaxf(fmaxf(S1[0], S1[1]), S1[2]);
#pragma unroll
            for (int i = 3; i < 15; i += 2) { mxa = fmaxf(fmaxf(mxa, S0[i]), S0[i + 1]); mxb = fmaxf(fmaxf(mxb, S1[i]), S1[i + 1]); }
            const float mx = fmaxf(fmaxf(mxa, S0[15]), fmaxf(mxb, S1[15]));
            const bool need = (mx > 16.0f) || (t == 0 && mx < -16.0f);
            if (__any(need)) {
                const u32x2 rr = __builtin_amdgcn_permlane32_swap(__float_as_uint(mx), __float_as_uint(mx), false, false);
                const float rmx = fmaxf(__uint_as_float(rr.x), __uint_as_float(rr.y));
                const float delta = ((rmx > 16.0f) || (t == 0 && rmx < -16.0f)) ? rmx : 0.0f;
                if (t > 0) {
                    const float alpha = __builtin_amdgcn_exp2f(-delta);
#pragma unroll
                    for (int d = 0; d < 4; ++d) O[d] *= alpha;
                    l *= alpha;
                }
                S0 -= delta; S1 -= delta; m += delta; shifted = true;
            }
            float ls0 = 0.f, ls1 = 0.f, ls2 = 0.f, ls3 = 0.f;
#pragma unroll
            for (int i = 0; i < 16; i += 2) {
                float e0 = __builtin_amdgcn_exp2f(S0[i]), e1 = __builtin_amdgcn_exp2f(S1[i]), e2 = __builtin_amdgcn_exp2f(S0[i + 1]), e3 = __builtin_amdgcn_exp2f(S1[i + 1]);
                asm("" : "+v"(e0)); asm("" : "+v"(e1)); asm("" : "+v"(e2)); asm("" : "+v"(e3));
                S0[i] = e0; S1[i] = e1; S0[i + 1] = e2; S1[i + 1] = e3;
                ls0 += e0; ls1 += e1; ls2 += e2; ls3 += e3;
            }
            l += (ls0 + ls1) + (ls2 + ls3);
            bf16x8 Pf[4];
            {
                u32x4 q;
                q.x = pk(S0[0], S0[1]); q.y = pk(S0[2], S0[3]); q.z = pk(S0[4], S0[5]); q.w = pk(S0[6], S0[7]); Pf[0] = __builtin_bit_cast(bf16x8, q);
                q.x = pk(S0[8], S0[9]); q.y = pk(S0[10], S0[11]); q.z = pk(S0[12], S0[13]); q.w = pk(S0[14], S0[15]); Pf[1] = __builtin_bit_cast(bf16x8, q);
                q.x = pk(S1[0], S1[1]); q.y = pk(S1[2], S1[3]); q.z = pk(S1[4], S1[5]); q.w = pk(S1[6], S1[7]); Pf[2] = __builtin_bit_cast(bf16x8, q);
                q.x = pk(S1[8], S1[9]); q.y = pk(S1[10], S1[11]); q.z = pk(S1[12], S1[13]); q.w = pk(S1[14], S1[15]); Pf[3] = __builtin_bit_cast(bf16x8, q);
            }
            __builtin_amdgcn_s_setprio(1);
#pragma unroll
            for (int d = 0; d < 4; ++d) O[d] = MFMA32(vf[d], Pf[0], O[d]);
#pragma unroll
            for (int kk = 1; kk < 4; ++kk) {
                const int co = ((2 * kk + hh) ^ vsw) << 4;
#pragma unroll
                for (int d = 0; d < 4; ++d) {
                    const bf16x8 v = *(const bf16x8*)(smem + vro + d * 4096 + co);
                    O[d] = MFMA32(v, Pf[kk], O[d]);
                }
            }
            __builtin_amdgcn_s_setprio(0);
        }
        if (t + 1 < ntiles) {
#pragma unroll
            for (int i = 0; i < 2; ++i) { *(u32x4*)(smem + nxt + kdst + i * 8192) = rk[i]; *(u32x4*)(smem + nxt + vdst + i * 8192) = rv[i]; }
        }
        __syncthreads();
    }
    const float lt = l + __shfl_xor(l, 32);
    const float inv = 1.0f / lt;
    int xo = XOFF + pair * 16384 + lane * 4;
    LAUNDER(xo);
    if (cm == 1 && ntw > 0) {
        const float sc = lam * inv;
#pragma unroll
        for (int d = 0; d < 4; ++d)
#pragma unroll
            for (int i = 0; i < 16; ++i) *(float*)(smem + xo + (d * 16 + i) * 256) = O[d][i] * sc;
    }
    __syncthreads();
    if (cm == 0 && ntw > 0) {
        float ss = 0.f;
#pragma unroll
        for (int d = 0; d < 4; ++d)
#pragma unroll
            for (int i = 0; i < 16; ++i) { const float v = O[d][i] * inv - *(const float*)(smem + xo + (d * 16 + i) * 256); O[d][i] = v; ss += v * v; }
        asm volatile("" ::: "memory");
        ss += __shfl_xor(ss, 32);
        const float rstd = rsqrtf(ss * (1.0f / 128.0f) + 1e-5f) * 0.8f;
        int tok = qtok0 + pair * 32 + r, hh4 = 4 * hh;
        LAUNDER(tok); LAUNDER(hh4);
        const u16* ga = (const u16*)(ws + WS_GA) + (size_t)tok * 768 + h * 128;
        u16* mo = (u16*)(ws + WS_MIX) + (size_t)tok * 1024 + 256 + h * 128;
#pragma unroll
        for (int d = 0; d < 4; ++d)
#pragma unroll
            for (int j4 = 0; j4 < 4; ++j4) {
                const int d0 = d * 32 + 8 * j4 + hh4;
                const u32x2 g = *(const u32x2*)(ga + d0);
                const f32x4 sg = *(const f32x4*)(p.subln_g + d0);
                const float v0 = O[d][4 * j4] * rstd * sg.x * bf_lo(g.x), v1 = O[d][4 * j4 + 1] * rstd * sg.y * bf_hi(g.x);
                const float v2 = O[d][4 * j4 + 2] * rstd * sg.z * bf_lo(g.y), v3 = O[d][4 * j4 + 3] * rstd * sg.w * bf_hi(g.y);
                u32x2 o; o.x = pk(v0, v1); o.y = pk(v2, v3);
                *(u32x2*)(mo + d0) = o;
                if (j4 & 1) asm volatile("" ::: "memory");
            }
    }
}

DI void pool_unit(const Params& p, int tid, int pu) {
    const int lane = tid & 63, w = tid >> 6, r = lane & 31, hh = lane >> 5;
    unsigned char* ws = p.ws;
    const float* U = (const float*)(ws + WS_U);
    const int tok0 = pu * 32; const bool smp = tok0 >= NP;
    float* E = (float*)smem;
    u16* PA = (u16*)(smem + 49152);
#pragma unroll 1
    for (int i = tid; i < 47 * 64; i += 512) {
        const int row = i >> 6, c4 = (i & 63) * 4; f32x4 v;
        if (row < 15) {
            if (smp) v = *(const f32x4*)(p.state_pool + ((size_t)((tok0 - NP) >> 5) * 15 + row) * 256 + c4);
            else if ((tok0 & 16383) == 0) v = (f32x4){0.f, 0.f, 0.f, 0.f};
            else v = *(const f32x4*)(U + (size_t)(tok0 - 15 + row) * 256 + c4);
        } else v = *(const f32x4*)(U + (size_t)(tok0 + row - 15) * 256 + c4);
        *(f32x4*)(E + row * 256 + c4) = v;
    }
    __syncthreads();
    {
        const int c = tid & 255, th = tid >> 8, g = c >> 6, wdw = 2 << g, tin0 = tok0 & 16383;
#pragma unroll 1
        for (int tt = 0; tt < 16; ++tt) {
            const int t = th * 16 + tt; float s = 0.f;
#pragma unroll 2
            for (int i = 0; i < wdw; ++i) s += E[(15 + t - i) * 256 + c];
            const int cnt = smp ? wdw : min(wdw, tin0 + t + 1);
            const float pooled = s / (float)cnt - E[(15 + t) * 256 + c];
            PA[t * 264 + c] = bf1(pooled);
        }
    }
    __syncthreads();
    {
        const int g = w >> 1, nb = w & 1;
        const u16* pw = (const u16*)(ws + WS_PWT) + (size_t)(g * 64 + nb * 32 + r) * 64 + hh * 8;
        f32x16 acc;
#pragma unroll
        for (int i = 0; i < 16; ++i) acc[i] = 0.f;
#pragma unroll
        for (int ks = 0; ks < 4; ++ks) {
            const bf16x8 a = *(const bf16x8*)(PA + r * 264 + g * 64 + ks * 16 + hh * 8);
            const bf16x8 b = *(const bf16x8*)(pw + ks * 16);
            acc = MFMA32(a, b, acc);
        }
        const int col = g * 64 + nb * 32 + r; const float pb = p.pool_b[col], ps = p.pool_scale[col];
        const float* G = (const float*)(ws + WS_GP); u16* mo = (u16*)(ws + WS_MIX);
#pragma unroll
        for (int i = 0; i < 16; ++i) {
            const int tok = tok0 + (i & 3) + 8 * (i >> 2) + 4 * hh;
            mo[(size_t)tok * 1024 + col] = bf1((acc[i] + pb) * ps * G[(size_t)tok * 256 + col]);
        }
    }
    __syncthreads();
}

DI void phase2(const Params& p, int tid) {
    unsigned char* ws = p.ws;
    const int lane = tid & 63;
    const float sa = wave_sum(p.lq1[lane] * p.lk1[lane]), sb = wave_sum(p.lq2[lane] * p.lk2[lane]);
    const float lam = __expf(sa) - __expf(sb) + 0.2f;
    const u16* KB = (const u16*)(ws + WS_KB); const u16* VT = (const u16*)(ws + WS_VT);
    for (int pi = blockIdx.x; pi < 768; pi += gridDim.x) {
        int bh, j;
        if (gridDim.x == 256) { const int xcd = blockIdx.x & 7, slot = blockIdx.x >> 3, rnd = pi >> 8; bh = rnd * 4 + (xcd & 3); j = slot + 32 * (xcd >> 2); }
        else { bh = pi >> 6; j = pi & 63; }
        const int b = bh / 6, h = bh % 6;
        for (int half = 0; half < 2; ++half) {
            const int qb = half == 0 ? 127 - j : j;
            attn_unit(p, tid, b * SEQ + qb * 128, h, KB + (size_t)b * SEQ * 768 + h * 128, VT + (size_t)bh * 128 * SEQ, SEQ, 2 * qb + 2, false, lam);
        }
    }
    unsigned* ctrl = (unsigned*)(ws + WS_CTRL);
    const u16* KS = (const u16*)(ws + WS_KBS); const u16* VS = (const u16*)(ws + WS_VTS);
    for (;;) {
        if (tid == 0) *(volatile int*)(smem + LDS_SLOT) = (int)atomicAdd(ctrl, 1u);
        __syncthreads();
        const int u = *(volatile int*)(smem + LDS_SLOT);
        __syncthreads();
        if (u >= 48 + 1032) break;
        if (u < 48) {
            const int b = u / 6, h = u % 6;
            attn_unit(p, tid, NP + b * 32, h, KS + (size_t)b * SKV * 768 + h * 128, VS + (size_t)u * 128 * SKV, SKV, 17, true, lam);
        } else pool_unit(p, tid, u - 48);
    }
}

struct EpiOutProj {
    static constexpr bool PERM = false, AFTER_DRAIN = false;
    const float* xp; const float* xs; float* y; float* st;
    __device__ __forceinline__ void operator()(const pg8::f32x4 (&acc)[2][2][4][2], const pg8::Unit& u, int wr, int wc, int fr_, int fq_) const {
        int fr = fr_, fq = fq_; LAUNDER(fr); LAUNDER(fq);
        const int r0 = u.pm * 256 + wr * 64 + fr, c0 = u.pn * 256 + wc * 32 + 4 * fq;
#pragma unroll
        for (int ai = 0; ai < 2; ++ai)
#pragma unroll
            for (int m = 0; m < 4; ++m) {
                const int R = r0 + ai * 128 + m * 16;
                const float* xr = R < NP ? xp + (size_t)R * 1024 : xs + (size_t)(R - NP) * 1024;
                float* yr = y + (size_t)R * 1024;
                float s1 = 0.f, s2 = 0.f;
#pragma unroll
                for (int bj = 0; bj < 2; ++bj)
#pragma unroll
                    for (int n = 0; n < 2; ++n) {
                        const int C = c0 + bj * 128 + n * 16;
                        const f32x4 xv = *(const f32x4*)(xr + C);
                        const f32x4 z = xv * DN_ALPHA + acc[ai][bj][m][n];
                        *(f32x4*)(yr + C) = z;
                        s1 += (z.x + z.y) + (z.z + z.w); s2 += (z.x * z.x + z.y * z.y) + (z.z * z.z + z.w * z.w);
                    }
                s1 += __shfl_xor(s1, 16); s2 += __shfl_xor(s2, 16); s1 += __shfl_xor(s1, 32); s2 += __shfl_xor(s2, 32);
                if (fq == 0) { f32x2 pr; pr.x = s1; pr.y = s2; *(f32x2*)(st + ((size_t)R * 16 + u.pn * 4 + wc) * 2) = pr; }
                asm volatile("" ::: "memory");
            }
    }
};

DI void phase3a(const Params& p) {
    pg8::Gemm g{(const pg8::bf16_t*)(p.ws + WS_MIX), (const pg8::bf16_t*)(p.ws + WS_WTOUT), NT, 1024, 1024};
    pg8::StaticOrder S; S.init(NT, 1024, (int)gridDim.x, (int)blockIdx.x);
    EpiOutProj E{p.x_prompt, p.x_sample, p.out + O_YP, (float*)(p.ws + WS_ST)};
    pg8::gemm_phase<EpiOutProj, pg8::StaticOrder, true, true>((PG8_LAS unsigned char*)smem, g, S, E);
}

DI void phase3b(const Params& p, int tid) {
    const int lane = tid & 63, gw = blockIdx.x * 8 + (tid >> 6), nw = gridDim.x * 8;
    const float* st = (const float*)(p.ws + WS_ST);
    float* y = p.out + O_YP;
    f32x4 g[4], bb[4];
#pragma unroll
    for (int j = 0; j < 4; ++j) { g[j] = *(const f32x4*)(p.ln_g + j * 256 + lane * 4); bb[j] = *(const f32x4*)(p.ln_b + j * 256 + lane * 4); }
    for (int R0 = gw; R0 < NT; R0 += 2 * nw) {
        f32x4 z[2][4]; f32x2 pr[2];
#pragma unroll
        for (int k = 0; k < 2; ++k) {
            const int R = R0 + k * nw;
            if (R < NT) {
                pr[k] = *(const f32x2*)(st + ((size_t)R * 16 + (lane & 15)) * 2);
#pragma unroll
                for (int j = 0; j < 4; ++j) z[k][j] = *(const f32x4*)(y + (size_t)R * 1024 + j * 256 + lane * 4);
            }
        }
#pragma unroll
        for (int k = 0; k < 2; ++k) {
            const int R = R0 + k * nw;
            if (R < NT) {
                float s1 = pr[k].x, s2 = pr[k].y;
#pragma unroll
                for (int o = 8; o > 0; o >>= 1) { s1 += __shfl_xor(s1, o); s2 += __shfl_xor(s2, o); }
                const float mu = s1 * (1.0f / 1024.0f);
                const float var = fmaxf(s2 * (1.0f / 1024.0f) - mu * mu, 0.f);
                const float rstd = rsqrtf(var + 1e-5f);
#pragma unroll
                for (int j = 0; j < 4; ++j) *(f32x4*)(y + (size_t)R * 1024 + j * 256 + lane * 4) = (z[k][j] - mu) * rstd * g[j] + bb[j];
            }
        }
    }
}

__global__ void __launch_bounds__(512) fwd_kernel(Params p) {
    cg::grid_group grid = cg::this_grid();
    const int tid = threadIdx.x;
    phase0(p, tid);
    if (p.ws == nullptr) grid.sync();
    grid_barrier((unsigned*)(p.ws + WS_CTRL) + 192);
    phase1(p, tid);
    grid_barrier((unsigned*)(p.ws + WS_CTRL) + 64);
    phase2(p, tid);
    grid_barrier((unsigned*)(p.ws + WS_CTRL) + 128);
    phase3a(p);
    grid_barrier((unsigned*)(p.ws + WS_CTRL) + 256);
    phase3b(p, tid);
}

extern "C" void kernel_launch(void* const* d_in, const int* in_sizes, int n_in, void* d_out, int out_size, void* d_ws, size_t ws_size, hipStream_t stream) {
    static int grid = 0;
    if (grid == 0) {
        if (n_in != 17 || ws_size < WS_END) { fprintf(stderr, "kernel_launch: unexpected n_in %d / ws_size %zu (need %zu)\n", n_in, ws_size, (size_t)WS_END); grid = -1; return; }
        int dev = 0, cus = 0, per_cu = 0;
        hipGetDevice(&dev);
        hipDeviceGetAttribute(&cus, hipDeviceAttributeMultiprocessorCount, dev);
        if (hipFuncSetAttribute((const void*)fwd_kernel, hipFuncAttributeMaxDynamicSharedMemorySize, LDS_BYTES) != hipSuccess) { fprintf(stderr, "kernel_launch: hipFuncSetAttribute failed\n"); grid = -1; return; }
        if (hipOccupancyMaxActiveBlocksPerMultiprocessor(&per_cu, (const void*)fwd_kernel, 512, LDS_BYTES) != hipSuccess || per_cu < 1) { fprintf(stderr, "kernel_launch: occupancy query gave %d\n", per_cu); per_cu = 1; }
        (void)hipGetLastError();
        grid = cus * per_cu;
        fprintf(stderr, "kernel_launch: grid %d (cus %d x %d)\n", grid, cus, per_cu);
    }
    if (grid < 0) return;
    Params p{};
    p.x_prompt = (const float*)d_in[0]; p.x_sample = (const float*)d_in[1]; p.cache_k = (const float*)d_in[2]; p.cache_v = (const float*)d_in[3]; p.state_pool = (const float*)d_in[4];
    p.w_in = (const float*)d_in[5]; p.pool_w = (const float*)d_in[6]; p.pool_b = (const float*)d_in[7]; p.pool_scale = (const float*)d_in[8];
    p.lq1 = (const float*)d_in[9]; p.lk1 = (const float*)d_in[10]; p.lq2 = (const float*)d_in[11]; p.lk2 = (const float*)d_in[12]; p.subln_g = (const float*)d_in[13];
    p.w_out = (const float*)d_in[14]; p.ln_g = (const float*)d_in[15]; p.ln_b = (const float*)d_in[16];
    p.out = (float*)d_out; p.ws = (unsigned char*)d_ws;
    if (hipMemsetAsync((char*)d_ws + WS_CTRL, 0, 4096, stream) != hipSuccess) { fprintf(stderr, "kernel_launch: hipMemsetAsync failed\n"); return; }
    void* args[] = {&p};
    hipError_t e = hipLaunchCooperativeKernel((const void*)fwd_kernel, dim3(grid), dim3(512), args, LDS_BYTES, stream);
    if (e != hipSuccess) fprintf(stderr, "kernel_launch: cooperative launch failed: %s (grid %d)\n", hipGetErrorString(e), grid);
}
```
